# Optimizing an MI355X kernel written in HIP

```python
import math, functools
import jax, jax.numpy as jnp
from jax import lax
import numpy as np

D_MODEL = 2048
BATCH = 16
SEQ = 256
DEPTH = 4
DEC_BATCH = 2
DEC_SEQ = 1024
PAST_LEN = 512

GRID_W = 64
N_MIXERS = 3
N_A_LAYERS = (DEPTH + 2) // 3
N_B_LAYERS = (DEPTH + 1) // 3
N_C_LAYERS = DEPTH // 3
A_HEAD_DIM = 128
A_HEADS = D_MODEL // (2 * A_HEAD_DIM)
A_QKV = 3 * A_HEADS * 2 * A_HEAD_DIM
B_HEAD_DIM = 128
B_HEADS = D_MODEL // B_HEAD_DIM
B_KV_HEADS = B_HEADS // 4
B_GROUP = B_HEADS // B_KV_HEADS
B_QKV = (B_HEADS + 2 * B_KV_HEADS) * B_HEAD_DIM
C_GROUPS = 4
C_GROUP_DIM = D_MODEL // C_GROUPS
D_FF = 4 * D_MODEL
Q_BLOCK = 128
ROPE_BASE = 10000.0
ALPHA = (2 * DEPTH) ** 0.25
BETA = (8 * DEPTH) ** -0.25
LN_EPS = 1e-5
RMS_EPS = 1e-6
N_MOD = 6

kernel_name = 'hybrid_diffattn_gqa_fourier_denoise_step'


def layer_norm(x, g, b):
    xf = x.astype(jnp.float32)
    mu = xf.mean(-1, keepdims=True)
    var = jnp.square(xf - mu).mean(-1, keepdims=True)
    y = (xf - mu) * lax.rsqrt(var + LN_EPS) * g.astype(jnp.float32) + b.astype(jnp.float32)
    return y.astype(x.dtype)


def rms_norm(x, g):
    xf = x.astype(jnp.float32)
    y = xf * lax.rsqrt(jnp.mean(jnp.square(xf), -1, keepdims=True) + RMS_EPS) * g.astype(jnp.float32)
    return y.astype(x.dtype)


def axial_rope_tables(n_tokens, dim):
    rows = n_tokens // GRID_W
    row = jnp.repeat(jnp.arange(rows), GRID_W).astype(jnp.float32)
    col = jnp.tile(jnp.arange(GRID_W), rows).astype(jnp.float32)
    n_freq = dim // 4
    inv_freq = ROPE_BASE ** (-jnp.arange(n_freq, dtype=jnp.float32) / n_freq)
    ang_r = row[:, None] * inv_freq
    ang_c = col[:, None] * inv_freq
    return (jnp.cos(ang_r), jnp.sin(ang_r), jnp.cos(ang_c), jnp.sin(ang_c))


def _rotate(x, cos, sin):
    x1, x2 = jnp.split(x, 2, axis=-1)
    return jnp.concatenate([x1 * cos - x2 * sin, x1 * sin + x2 * cos], axis=-1)


def apply_axial_rope(x, tables):
    cos_r, sin_r, cos_c, sin_c = tables
    shape = (x.shape[1],) + (1,) * (x.ndim - 3) + (cos_r.shape[-1],)
    half = x.shape[-1] // 2
    xf = x.astype(jnp.float32)
    out = jnp.concatenate([
        _rotate(xf[..., :half], cos_r.reshape(shape), sin_r.reshape(shape)),
        _rotate(xf[..., half:], cos_c.reshape(shape), sin_c.reshape(shape))], axis=-1)
    return out.astype(x.dtype)


def sweep_query_blocks(attend, q):
    b, s = q.shape[0], q.shape[1]
    n_blocks = s // Q_BLOCK
    qb = jnp.moveaxis(q.reshape((b, n_blocks, Q_BLOCK) + q.shape[2:]), 1, 0)
    out = jnp.moveaxis(lax.map(attend, qb), 0, 1)
    return out.reshape((b, s) + out.shape[3:])


def diff_attention(q, k, v, lam):
    scale = A_HEAD_DIM ** -0.5

    def attend(qb):
        s = jnp.einsum('bqhpd,bkhpd->bhpqk', qb, k, preferred_element_type=jnp.float32) * scale
        p = jax.nn.softmax(s, axis=-1)
        a = p[:, :, 0] - lam * p[:, :, 1]
        return jnp.einsum('bhqk,bkhe->bqhe', a.astype(v.dtype), v)

    return sweep_query_blocks(attend, q)


def diff_project(u, w_qkv):
    b, s, _ = u.shape
    q, k, v = jnp.split(u @ w_qkv, 3, axis=-1)
    return (q.reshape(b, s, A_HEADS, 2, A_HEAD_DIM),
            k.reshape(b, s, A_HEADS, 2, A_HEAD_DIM),
            v.reshape(b, s, A_HEADS, 2 * A_HEAD_DIM))


def diff_lambda(lam_params, layer_idx):
    lam_init = 0.8 - 0.6 * math.exp(-0.3 * layer_idx)
    lp = lam_params.astype(jnp.float32)
    lam = jnp.exp(jnp.sum(lp[0] * lp[1])) - jnp.exp(jnp.sum(lp[2] * lp[3])) + lam_init
    return lam, lam_init


def diff_output(o, subln_g, lam_init, w_o):
    b, s = o.shape[0], o.shape[1]
    o = rms_norm(o, subln_g) * (1.0 - lam_init)
    return o.reshape(b, s, -1) @ w_o


def diff_mixer_context(u, w_qkv, w_o, lam, lam_init, subln_g):
    q, k, v = diff_project(u, w_qkv)
    o = diff_attention(q, k, v, lam)
    return diff_output(o, subln_g, lam_init, w_o), (k, v)


def diff_mixer_latent(u, ctx_k, ctx_v, rope, w_qkv, w_o, lam, lam_init, subln_g):
    q, k, v = diff_project(u, w_qkv)
    q = apply_axial_rope(q, rope)
    k = apply_axial_rope(k, rope)
    k_all = jnp.concatenate([ctx_k, k], axis=1)
    v_all = jnp.concatenate([ctx_v, v], axis=1)
    o = diff_attention(q, k_all, v_all, lam)
    return diff_output(o, subln_g, lam_init, w_o), None


def gqa_attention(q, k, v):
    scale = B_HEAD_DIM ** -0.5

    def attend(qb):
        s = jnp.einsum('bqngd,bknd->bngqk', qb, k, preferred_element_type=jnp.float32) * scale
        p = jax.nn.softmax(s, axis=-1)
        return jnp.einsum('bngqk,bknd->bqngd', p.astype(v.dtype), v)

    return sweep_query_blocks(attend, q)


def gqa_project(u, w_qkv, q_g, k_g):
    b, s, _ = u.shape
    qkv = u @ w_qkv
    hq = B_HEADS * B_HEAD_DIM
    hk = B_KV_HEADS * B_HEAD_DIM
    q = qkv[..., :hq].reshape(b, s, B_KV_HEADS, B_GROUP, B_HEAD_DIM)
    k = qkv[..., hq:hq + hk].reshape(b, s, B_KV_HEADS, B_HEAD_DIM)
    v = qkv[..., hq + hk:].reshape(b, s, B_KV_HEADS, B_HEAD_DIM)
    return rms_norm(q, q_g), rms_norm(k, k_g), v


def gqa_mixer_context(u, w_qkv, w_o, q_g, k_g):
    b, s, _ = u.shape
    q, k, v = gqa_project(u, w_qkv, q_g, k_g)
    o = gqa_attention(q, k, v)
    return o.reshape(b, s, -1) @ w_o, (k, v)


def gqa_mixer_latent(u, ctx_k, ctx_v, rope, w_qkv, w_o, q_g, k_g):
    b, s, _ = u.shape
    q, k, v = gqa_project(u, w_qkv, q_g, k_g)
    q = apply_axial_rope(q, rope)
    k = apply_axial_rope(k, rope)
    k_all = jnp.concatenate([ctx_k, k], axis=1)
    v_all = jnp.concatenate([ctx_v, v], axis=1)
    o = gqa_attention(q, k_all, v_all)
    return o.reshape(b, s, -1) @ w_o, None


def fourier_mixer(u, w_f):
    b, s, _ = u.shape
    uf = u.astype(jnp.float32).reshape(b, s, C_GROUPS, C_GROUP_DIM)
    y = jnp.fft.fft2(uf, axes=(1, 3), norm='ortho').real
    return y.reshape(b, s, D_MODEL).astype(u.dtype) @ w_f, None


def modulation(cond, w_mod, b_mod):
    return (jax.nn.silu(cond) @ w_mod + b_mod).reshape(cond.shape[0], N_MOD, D_MODEL)


def sq_relu_mlp(u, w_up, w_down):
    return jnp.square(jax.nn.relu(u @ w_up)) @ w_down


def trunk_block(x, mod, mixer, ln_g, ln_b, w_up, w_down):
    shift1, scale1, gate1, shift2, scale2, gate2 = (mod[:, None, i] for i in range(N_MOD))
    mixed, aux = mixer(x * (1 + scale1) + shift1)
    x = layer_norm(ALPHA * x + gate1 * mixed, ln_g[0], ln_b[0])
    ff = sq_relu_mlp(x * (1 + scale2) + shift2, w_up, w_down)
    x = layer_norm(ALPHA * x + gate2 * ff, ln_g[1], ln_b[1])
    return x, aux


def setup_inputs(seed: int = 0) -> dict:
    key = jax.random.key(seed)
    ks = jax.random.split(key, 24)
    f32 = jnp.float32

    def nrm(k, shape, scale):
        return jax.random.normal(k, shape, f32) * scale

    return {
        'x_prompt': nrm(ks[0], (BATCH, SEQ, D_MODEL), 1.0),
        'x_sample': nrm(ks[1], (DEC_BATCH, DEC_SEQ, D_MODEL), 1.0),
        'cache_a_k': nrm(ks[2], (DEC_BATCH, N_A_LAYERS, PAST_LEN, A_HEADS, 2, A_HEAD_DIM), 1.0),
        'cache_a_v': nrm(ks[3], (DEC_BATCH, N_A_LAYERS, PAST_LEN, A_HEADS, 2 * A_HEAD_DIM), 1.0),
        'cache_b_k': nrm(ks[4], (DEC_BATCH, N_B_LAYERS, PAST_LEN, B_KV_HEADS, B_HEAD_DIM), 1.0),
        'cache_b_v': nrm(ks[5], (DEC_BATCH, N_B_LAYERS, PAST_LEN, B_KV_HEADS, B_HEAD_DIM), 1.0),
        'c': nrm(ks[6], (DEC_BATCH, D_MODEL), 1.0),
        'c_ctx': nrm(ks[7], (D_MODEL,), 1.0),
        'w_mod': nrm(ks[8], (DEPTH, D_MODEL, N_MOD * D_MODEL), 0.5 * D_MODEL ** -0.5),
        'b_mod': nrm(ks[9], (DEPTH, N_MOD * D_MODEL), 0.02),
        'ln_g': 1.0 + nrm(ks[10], (DEPTH, 2, D_MODEL), 0.02),
        'ln_b': nrm(ks[11], (DEPTH, 2, D_MODEL), 0.02),
        'w_up': nrm(ks[12], (DEPTH, D_MODEL, D_FF), D_MODEL ** -0.5),
        'w_down': nrm(ks[13], (DEPTH, D_FF, D_MODEL), BETA * D_FF ** -0.5),
        'a_w_qkv': nrm(ks[14], (N_A_LAYERS, D_MODEL, A_QKV), D_MODEL ** -0.5),
        'a_w_o': nrm(ks[15], (N_A_LAYERS, 2 * A_HEADS * A_HEAD_DIM, D_MODEL), BETA * (2 * A_HEADS * A_HEAD_DIM) ** -0.5),
        'a_lambda': nrm(ks[16], (N_A_LAYERS, 4, A_HEAD_DIM), 0.1),
        'a_subln_g': 1.0 + nrm(ks[17], (N_A_LAYERS, 2 * A_HEAD_DIM), 0.02),
        'b_w_qkv': nrm(ks[18], (N_B_LAYERS, D_MODEL, B_QKV), D_MODEL ** -0.5),
        'b_w_o': nrm(ks[19], (N_B_LAYERS, B_HEADS * B_HEAD_DIM, D_MODEL), BETA * (B_HEADS * B_HEAD_DIM) ** -0.5),
        'b_q_norm_g': 1.0 + nrm(ks[20], (N_B_LAYERS, B_HEAD_DIM), 0.02),
        'b_k_norm_g': 1.0 + nrm(ks[21], (N_B_LAYERS, B_HEAD_DIM), 0.02),
        'c_w_f': nrm(ks[22], (N_C_LAYERS, D_MODEL, D_MODEL), BETA * D_MODEL ** -0.5),
    }


def reference(x_prompt, x_sample, cache_a_k, cache_a_v, cache_b_k, cache_b_v, c, c_ctx,
              w_mod, b_mod, ln_g, ln_b, w_up, w_down,
              a_w_qkv, a_w_o, a_lambda, a_subln_g,
              b_w_qkv, b_w_o, b_q_norm_g, b_k_norm_g, c_w_f):
    n_lat = x_sample.shape[1]
    rope_a = axial_rope_tables(n_lat, A_HEAD_DIM)
    rope_b = axial_rope_tables(n_lat, B_HEAD_DIM)

    y_p, y_s = x_prompt, x_sample
    a_ks, a_vs, b_ks, b_vs = [], [], [], []
    for l in range(DEPTH):
        kind, j = l % N_MIXERS, l // N_MIXERS
        mod_p = modulation(c_ctx[None, :], w_mod[l], b_mod[l])
        mod_s = modulation(c, w_mod[l], b_mod[l])
        if kind == 0:
            lam, lam_init = diff_lambda(a_lambda[j], l)
            ctx_mix = functools.partial(diff_mixer_context, w_qkv=a_w_qkv[j], w_o=a_w_o[j],
                                        lam=lam, lam_init=lam_init, subln_g=a_subln_g[j])
            lat_mix = functools.partial(diff_mixer_latent, ctx_k=cache_a_k[:, j], ctx_v=cache_a_v[:, j],
                                        rope=rope_a, w_qkv=a_w_qkv[j], w_o=a_w_o[j],
                                        lam=lam, lam_init=lam_init, subln_g=a_subln_g[j])
        elif kind == 1:
            ctx_mix = functools.partial(gqa_mixer_context, w_qkv=b_w_qkv[j], w_o=b_w_o[j],
                                        q_g=b_q_norm_g[j], k_g=b_k_norm_g[j])
            lat_mix = functools.partial(gqa_mixer_latent, ctx_k=cache_b_k[:, j], ctx_v=cache_b_v[:, j],
                                        rope=rope_b, w_qkv=b_w_qkv[j], w_o=b_w_o[j],
                                        q_g=b_q_norm_g[j], k_g=b_k_norm_g[j])
        else:
            ctx_mix = functools.partial(fourier_mixer, w_f=c_w_f[j])
            lat_mix = functools.partial(fourier_mixer, w_f=c_w_f[j])

        y_p, aux = trunk_block(y_p, mod_p, ctx_mix, ln_g[l], ln_b[l], w_up[l], w_down[l])
        y_s, _ = trunk_block(y_s, mod_s, lat_mix, ln_g[l], ln_b[l], w_up[l], w_down[l])
        if kind == 0:
            a_ks.append(aux[0])
            a_vs.append(aux[1])
        elif kind == 1:
            b_ks.append(aux[0])
            b_vs.append(aux[1])

    new_a_k = jnp.stack(a_ks, axis=1)
    new_a_v = jnp.stack(a_vs, axis=1)
    new_b_k = jnp.stack(b_ks, axis=1)
    new_b_v = jnp.stack(b_vs, axis=1)
    return (y_p, y_s, new_a_k, new_a_v, new_b_k, new_b_v)
```

```cpp
#include <hip/hip_runtime.h>
#include <cstdio>
#include <cstdint>
namespace pg8 {
#define PG8_LAS __attribute__((address_space(3)))
typedef unsigned short bf16_t;
typedef short bf16x8 __attribute__((ext_vector_type(8)));
typedef float f32x4 __attribute__((ext_vector_type(4)));
typedef unsigned u32x4 __attribute__((ext_vector_type(4)));
constexpr int BM = 256, BK = 64, HALF = 128, HTB = HALF * BK * 2  , STAGE_BYTES = 8 * HTB, NXCD = 8, WGM = 8;

__host__ __device__ __forceinline__ int lds_byte(int r, int c) { const int st = (r >> 4) * 2 + (c >> 5), rr = r & 15, cc = c & 31, ob = rr * 64 + cc * 2; return st * 1024 + (ob ^ (((ob >> 9) & 1) << 5)); }
__host__ __device__ __forceinline__ void stage_rc(int b, int& R, int& C) { const int st = b / 1024, sb = b % 1024, swz = sb ^ (((sb >> 9) & 1) << 5); R = (st >> 1) * 16 + swz / 64; C = (st & 1) * 32 + (swz % 64) / 2; }
__host__ __device__ __forceinline__ int perm32(int rho) { const int n = rho >> 4, i = rho & 15; return 8 * (i >> 2) + 4 * n + (i & 3); }

struct Unit { int pm, pn; };
struct Gemm { const bf16_t* A; const bf16_t* Bt; int M, N, K; };

struct StaticOrder {
    int nM, nN, nwg, G, c;
    __host__ __device__ void init(int M, int N, int G_, int c_) { nM = M / BM; nN = N / BM; nwg = nM * nN; G = G_; c = c_; }
    __host__ __device__ bool next(int i, Unit& u) const {
        const long L = (long)i * G + c; if (L >= nwg) return false;
        int wgid = (int)L; { const int q = nwg / NXCD, r = nwg % NXCD, xcd = wgid % NXCD, off = wgid / NXCD; wgid = (xcd < r ? xcd * (q + 1) : r * (q + 1) + (xcd - r) * q) + off; }
        const int nig = WGM * nN, gid = wgid / nig, fm = gid * WGM, gsz = (nM - fm) < WGM ? (nM - fm) : WGM;
        u.pm = fm + ((wgid % nig) % gsz); u.pn = (wgid % nig) / gsz; return true;
    }
    __device__ __forceinline__ void a_ready(const Unit&) const {}
    __device__ __forceinline__ void done(const Unit&) const {}
};

__device__ __forceinline__ unsigned cvt_pk_bf16(float lo, float hi) { unsigned r; asm volatile("v_cvt_pk_bf16_f32 %0, %1, %2" : "=v"(r) : "v"(lo), "v"(hi)); return r; }

struct Route { bf16_t* ob; float* of; int ldb, ldf; };
template <class Router> struct EpiRoute {
    static constexpr bool PERM = true, AFTER_DRAIN = false;
    Router R;
    __device__ __forceinline__ void operator()(const f32x4 (&acc)[2][2][4][2], const Unit& u, int wr, int wc, int fr, int fq) const {
        const Route rt = R(u);
        const int r0 = wr * 64 + fr, c0 = wc * 32 + 8 * fq;
        if (rt.ob) {
#pragma unroll
            for (int ai = 0; ai < 2; ++ai)
#pragma unroll
                for (int m = 0; m < 4; ++m) { bf16_t* rowp = rt.ob + (size_t)(r0 + ai * HALF + m * 16) * rt.ldb + c0;
#pragma unroll
                    for (int bj = 0; bj < 2; ++bj) { const f32x4 v0 = acc[ai][bj][m][0], v1 = acc[ai][bj][m][1];
                        u32x4 w; w.x = cvt_pk_bf16(v0[0], v0[1]); w.y = cvt_pk_bf16(v0[2], v0[3]); w.z = cvt_pk_bf16(v1[0], v1[1]); w.w = cvt_pk_bf16(v1[2], v1[3]);
                        *(u32x4*)(rowp + bj * HALF) = w; } }
        }
        if (rt.of) {
#pragma unroll
            for (int ai = 0; ai < 2; ++ai)
#pragma unroll
                for (int m = 0; m < 4; ++m) { float* rowp = rt.of + (size_t)(r0 + ai * HALF + m * 16) * rt.ldf + c0;
#pragma unroll
                    for (int bj = 0; bj < 2; ++bj) { *(f32x4*)(rowp + bj * HALF) = acc[ai][bj][m][0]; *(f32x4*)(rowp + bj * HALF + 4) = acc[ai][bj][m][1]; } }
        }
    }
};
struct EpiRelu2 {
    static constexpr bool PERM = true, AFTER_DRAIN = false;
    bf16_t* O; int ldc;
    __device__ __forceinline__ void operator()(const f32x4 (&acc)[2][2][4][2], const Unit& u, int wr, int wc, int fr, int fq) const {
        const int row0 = u.pm * BM + wr * 64 + fr, col0 = u.pn * BM + wc * 32 + 8 * fq;
#pragma unroll
        for (int ai = 0; ai < 2; ++ai)
#pragma unroll
            for (int m = 0; m < 4; ++m) { bf16_t* rowp = O + (size_t)(row0 + ai * HALF + m * 16) * ldc + col0;
#pragma unroll
                for (int bj = 0; bj < 2; ++bj) { f32x4 v0 = acc[ai][bj][m][0], v1 = acc[ai][bj][m][1];
#pragma unroll
                    for (int j = 0; j < 4; ++j) { const float a = fmaxf(v0[j], 0.f), b = fmaxf(v1[j], 0.f); v0[j] = a * a; v1[j] = b * b; }
                    u32x4 w; w.x = cvt_pk_bf16(v0[0], v0[1]); w.y = cvt_pk_bf16(v0[2], v0[3]); w.z = cvt_pk_bf16(v1[0], v1[1]); w.w = cvt_pk_bf16(v1[2], v1[3]);
                    *(u32x4*)(rowp + bj * HALF) = w; } }
    }
};
struct EpiResid {
    static constexpr bool PERM = false, AFTER_DRAIN = false;
    const float* X; float* H; const float* gate; int ldc, gstride; float alpha;
    __device__ __forceinline__ void operator()(const f32x4 (&acc)[2][2][4][2], const Unit& u, int wr, int wc, int fr, int fq) const {
        const int row0 = u.pm * BM + wr * 64 + fr, col0 = u.pn * BM + wc * 32 + 4 * fq;
        const int cond = u.pm < 16 ? 0 : 1 + ((u.pm - 16) >> 2);
        const float* g = gate + (size_t)cond * gstride + col0;
        f32x4 gv[2][2];
#pragma unroll
        for (int bj = 0; bj < 2; ++bj)
#pragma unroll
            for (int n = 0; n < 2; ++n) gv[bj][n] = *(const f32x4*)(g + bj * HALF + n * 16);
#pragma unroll
        for (int ai = 0; ai < 2; ++ai)
#pragma unroll
            for (int m = 0; m < 4; ++m) { const size_t off = (size_t)(row0 + ai * HALF + m * 16) * ldc + col0;
#pragma unroll
                for (int bj = 0; bj < 2; ++bj)
#pragma unroll
                    for (int n = 0; n < 2; ++n) { const f32x4 xv = *(const f32x4*)(X + off + bj * HALF + n * 16);
                        *(f32x4*)(H + off + bj * HALF + n * 16) = xv * alpha + gv[bj][n] * acc[ai][bj][m][n]; }
                asm volatile("" ::: "memory"); }
    }
};

template <class Epi, class Sched, bool ALIGN_EPI = false, bool SP2 = false>
__device__ __forceinline__ void gemm_phase(PG8_LAS unsigned char* lds, const Gemm g, const Sched& S, const Epi& E, const int wid  ) {
    const int lane = (int)__builtin_amdgcn_mbcnt_hi(~0u, __builtin_amdgcn_mbcnt_lo(~0u, 0u)), tid = wid * 64 + lane, wr = wid >> 2, wc = wid & 3, fr = lane & 15, fq = lane >> 4;
    const int K = g.K, nt = K / BK;
    unsigned voffA[2], voffB[2];
#pragma unroll
    for (int i = 0; i < 2; ++i) { int R, C; stage_rc(tid * 16 + i * 8192, R, C); const int Rb = Epi::PERM ? ((R & ~31) + perm32(R & 31)) : R;
        voffA[i] = (unsigned)(R * K + C) * 2u; voffB[i] = (unsigned)(Rb * K + C) * 2u; }
    const size_t kstep = (size_t)(BK * 2);
    const size_t hstep = (size_t)HALF * K * 2;
    const size_t tstep = 2 * hstep;
    const unsigned ldsw = (unsigned)wid * 1024u;
    const int aoff = lds_byte(wr * 64 + fr, fq * 8), boff = lds_byte(wc * 32 + fr, fq * 8);
#define PG8_SA(b, h) (((b) * 2 + (h)) * HTB)
#define PG8_SB(b, h) ((4 + (b) * 2 + (h)) * HTB)
#define PG8_STAGE(bufoff, gbase, voff) do { _Pragma("unroll") for (int _i = 0; _i < 2; ++_i) \
        __builtin_amdgcn_global_load_lds((const unsigned*)((const char*)(gbase) + (voff)[_i]), (PG8_LAS unsigned*)(lds + (bufoff) + ldsw + _i * 8192), 16, 0, 0); } while (0)
#define PG8_LDA(dst, b, h) do { _Pragma("unroll") for (int m = 0; m < 4; ++m) _Pragma("unroll") for (int k = 0; k < 2; ++k) dst[m][k] = *(const PG8_LAS bf16x8*)(lds + PG8_SA(b, h) + aoff + m * 2048 + k * 1024); } while (0)
#define PG8_LDB(dst, b, h) do { _Pragma("unroll") for (int n = 0; n < 2; ++n) _Pragma("unroll") for (int k = 0; k < 2; ++k) dst[n][k] = *(const PG8_LAS bf16x8*)(lds + PG8_SB(b, h) + boff + n * 2048 + k * 1024); } while (0)
#define PG8_MMA(ai, bj, At, Bt) do { __builtin_amdgcn_s_setprio(1); _Pragma("unroll") for (int m = 0; m < 4; ++m) _Pragma("unroll") for (int n = 0; n < 2; ++n) _Pragma("unroll") for (int k = 0; k < 2; ++k) \
        acc[ai][bj][m][n] = __builtin_amdgcn_mfma_f32_16x16x32_bf16(Bt[n][k], At[m][k], acc[ai][bj][m][n], 0, 0, 0); __builtin_amdgcn_s_setprio(0); } while (0)
#define PG8_WAIT_V(n) asm volatile("s_waitcnt vmcnt(" #n ")" ::: "memory")
#define PG8_WAIT_L(n) asm volatile("s_waitcnt lgkmcnt(" #n ")" ::: "memory")
#define PG8_BAR __builtin_amdgcn_s_barrier()
#define PG8_SCHED __builtin_amdgcn_sched_barrier(0)
    Unit cur, nxt; int ui = 0;
    if (!S.next(0, cur)) return;
    f32x4 acc[2][2][4][2];
#pragma unroll
    for (int a = 0; a < 2; ++a)
#pragma unroll
        for (int b = 0; b < 2; ++b)
#pragma unroll
            for (int m = 0; m < 4; ++m)
#pragma unroll
                for (int n = 0; n < 2; ++n) acc[a][b][m][n] = (f32x4){0.f, 0.f, 0.f, 0.f};
    bf16x8 At[4][2], B0[2][2], B1[2][2];
    const char* cA = (const char*)g.A + (size_t)cur.pm * tstep; const char* cB = (const char*)g.Bt + (size_t)cur.pn * tstep;
    S.a_ready(cur);
    if constexpr (SP2) {
        PG8_STAGE(PG8_SB(0, 0), cB, voffB); PG8_STAGE(PG8_SB(0, 1), cB + hstep, voffB); PG8_STAGE(PG8_SA(0, 0), cA, voffA); PG8_STAGE(PG8_SA(0, 1), cA + hstep, voffA);
        if (wr == 1) PG8_BAR;
        PG8_WAIT_V(2); PG8_BAR;
        PG8_STAGE(PG8_SB(1, 0), cB + kstep, voffB); PG8_STAGE(PG8_SA(1, 0), cA + kstep, voffA); PG8_STAGE(PG8_SB(1, 1), cB + hstep + kstep, voffB);
        PG8_WAIT_V(6); PG8_BAR;
    } else {
        PG8_STAGE(PG8_SB(0, 0), cB, voffB); PG8_STAGE(PG8_SA(0, 0), cA, voffA); PG8_STAGE(PG8_SB(0, 1), cB + hstep, voffB); PG8_STAGE(PG8_SA(0, 1), cA + hstep, voffA);
        if (wr == 1) PG8_BAR;
        PG8_WAIT_V(4); PG8_BAR;
        PG8_STAGE(PG8_SB(1, 0), cB + kstep, voffB); PG8_STAGE(PG8_SA(1, 0), cA + kstep, voffA); PG8_STAGE(PG8_SB(1, 1), cB + hstep + kstep, voffB);
        PG8_WAIT_V(6); PG8_BAR;
    }
    for (;;) {
        const bool has_next = S.next(ui + 1, nxt);
        const char* nA = has_next ? (const char*)g.A + (size_t)nxt.pm * tstep : cA; const char* nB = has_next ? (const char*)g.Bt + (size_t)nxt.pn * tstep : cB;
        for (int t = 0; t < nt; t += 2) {
            const bool last = (t == nt - 2);
            const char* a1 = cA + (size_t)(t + 1) * kstep;
            const char* a2 = last ? nA : cA + (size_t)(t + 2) * kstep; const char* b2 = last ? nB : cB + (size_t)(t + 2) * kstep;
            const char* a3 = a2 + kstep; const char* b3 = b2 + kstep;
            if (last && has_next) S.a_ready(nxt);
            if constexpr (SP2) {
            PG8_LDB(B0, 0, 0); PG8_LDB(B1, 0, 1); PG8_SCHED; PG8_LDA(At, 0, 0); PG8_STAGE(PG8_SA(1, 1), a1 + hstep, voffA);
            PG8_WAIT_V(8); PG8_WAIT_L(0); PG8_BAR; PG8_MMA(0, 0, At, B0); PG8_MMA(0, 1, At, B1); PG8_BAR; PG8_SCHED;
            PG8_LDA(At, 0, 1); PG8_STAGE(PG8_SB(0, 0), b2, voffB); PG8_STAGE(PG8_SB(0, 1), b2 + hstep, voffB); PG8_STAGE(PG8_SA(0, 0), a2, voffA);
            PG8_WAIT_V(8); PG8_WAIT_L(0); PG8_BAR; PG8_MMA(1, 0, At, B0); PG8_MMA(1, 1, At, B1); PG8_BAR; PG8_SCHED;
            PG8_LDB(B0, 1, 0); PG8_LDB(B1, 1, 1); PG8_SCHED; PG8_LDA(At, 1, 0); PG8_STAGE(PG8_SA(0, 1), a2 + hstep, voffA);
            PG8_WAIT_V(8); PG8_WAIT_L(0); PG8_BAR; PG8_MMA(0, 0, At, B0); PG8_MMA(0, 1, At, B1); PG8_BAR; PG8_SCHED;
            PG8_LDA(At, 1, 1); PG8_STAGE(PG8_SB(1, 0), b3, voffB); PG8_STAGE(PG8_SB(1, 1), b3 + hstep, voffB); PG8_STAGE(PG8_SA(1, 0), a3, voffA);
            PG8_WAIT_V(8); PG8_WAIT_L(0); PG8_BAR; PG8_MMA(1, 0, At, B0); PG8_MMA(1, 1, At, B1); PG8_BAR; PG8_SCHED;
            } else {
            PG8_LDB(B0, 0, 0); PG8_SCHED; PG8_LDA(At, 0, 0); PG8_STAGE(PG8_SA(1, 1), a1 + hstep, voffA);
            PG8_WAIT_L(8); PG8_BAR; PG8_WAIT_L(0); PG8_MMA(0, 0, At, B0); PG8_BAR; PG8_SCHED;
            PG8_LDB(B1, 0, 1); PG8_STAGE(PG8_SB(0, 0), b2, voffB);
            PG8_BAR; PG8_WAIT_L(0); PG8_MMA(0, 1, At, B1); PG8_BAR;
            PG8_LDA(At, 0, 1); PG8_STAGE(PG8_SA(0, 0), a2, voffA);
            PG8_BAR; PG8_WAIT_L(0); PG8_MMA(1, 0, At, B0); PG8_BAR; PG8_SCHED;
            PG8_STAGE(PG8_SB(0, 1), b2 + hstep, voffB);
            PG8_WAIT_V(6); PG8_BAR; PG8_MMA(1, 1, At, B1); PG8_BAR;
            PG8_LDB(B0, 1, 0); PG8_SCHED; PG8_LDA(At, 1, 0); PG8_STAGE(PG8_SA(0, 1), a2 + hstep, voffA);
            PG8_WAIT_L(8); PG8_BAR; PG8_WAIT_L(0); PG8_MMA(0, 0, At, B0); PG8_BAR; PG8_SCHED;
            PG8_LDB(B1, 1, 1); PG8_STAGE(PG8_SB(1, 0), b3, voffB);
            PG8_BAR; PG8_WAIT_L(0); PG8_MMA(0, 1, At, B1); PG8_BAR;
            PG8_LDA(At, 1, 1); PG8_STAGE(PG8_SA(1, 0), a3, voffA);
            PG8_BAR; PG8_WAIT_L(0); PG8_MMA(1, 0, At, B0); PG8_BAR; PG8_SCHED;
            PG8_STAGE(PG8_SB(1, 1), b3 + hstep, voffB);
            PG8_WAIT_V(6); PG8_BAR; PG8_MMA(1, 1, At, B1); PG8_BAR;
            }
        }
        if constexpr (ALIGN_EPI) { if (wr == 0) PG8_BAR; }
        if constexpr (!Epi::AFTER_DRAIN) { E(acc, cur, wr, wc, fr, fq); S.done(cur); }
        if (!has_next) break;
#pragma unroll
        for (int a = 0; a < 2; ++a)
#pragma unroll
            for (int b = 0; b < 2; ++b)
#pragma unroll
                for (int m = 0; m < 4; ++m)
#pragma unroll
                    for (int n = 0; n < 2; ++n) acc[a][b][m][n] = (f32x4){0.f, 0.f, 0.f, 0.f};
        cur = nxt; cA = nA; cB = nB; ++ui;
        if constexpr (ALIGN_EPI) { if (wr == 1) PG8_BAR; }
    }
    PG8_WAIT_V(0);
    if constexpr (!ALIGN_EPI) { if (wr == 0) PG8_BAR; }
    PG8_BAR;
    if constexpr (Epi::AFTER_DRAIN) { E.fused(acc, cur, wr, wc, fr, fq, lds, wid, lane); S.done(cur); }
#undef PG8_SA
#undef PG8_SB
#undef PG8_STAGE
#undef PG8_LDA
#undef PG8_LDB
#undef PG8_MMA
#undef PG8_WAIT_V
#undef PG8_WAIT_L
#undef PG8_BAR
#undef PG8_SCHED
}
}
#define GAS __attribute__((address_space(1)))
#define LAS __attribute__((address_space(3)))
typedef unsigned short bf16;
typedef unsigned v4u __attribute__((ext_vector_type(4)));
typedef float f32x4 __attribute__((ext_vector_type(4)));
typedef short bf16x8 __attribute__((ext_vector_type(8)));
typedef GAS unsigned gu32;
typedef GAS unsigned long long gu64;
#define RLX_AGENT __ATOMIC_RELAXED, __HIP_MEMORY_SCOPE_AGENT
#define LDS_WAIT() asm volatile("s_waitcnt lgkmcnt(0)" ::: "memory")
#define VM_WAIT() asm volatile("s_waitcnt vmcnt(0)" ::: "memory")
__device__ __forceinline__ unsigned long long rt() { return __builtin_amdgcn_s_memrealtime(); }
__device__ __forceinline__ unsigned f2bf(float f) { unsigned u = __builtin_bit_cast(unsigned, f); return (u + 0x7fffu + ((u >> 16) & 1u)) >> 16; }
__device__ __forceinline__ unsigned pk2(float lo, float hi) { return f2bf(lo) | (f2bf(hi) << 16); }

#define XB_TMO      128
#define XB_XCNT(j)  (256  + 64 * (j))
#define XB_XSUB(j)  (1280 + 64 * (j))
#define XB_XGEN(j)  (2304 + 64 * (j))
#define XB_TOP      3328
#define XB_TOPGEN   3392
#define XCD_BAR_WORDS 3456
#define XB_SPIN_CAP (1u << 18)

__device__ __forceinline__ unsigned xb_ld(unsigned* p)              { return __hip_atomic_load(p, __ATOMIC_RELAXED, __HIP_MEMORY_SCOPE_AGENT); }
__device__ __forceinline__ unsigned xb_add(unsigned* p, unsigned v) { return __hip_atomic_fetch_add(p, v, __ATOMIC_RELAXED, __HIP_MEMORY_SCOPE_AGENT); }
__device__ __forceinline__ unsigned xb_xcc_id() { return (unsigned)__builtin_amdgcn_s_getreg((3 << 11) | 20) & 0xFu; }
#define XB_SPIN(cond, bar) do { unsigned _sp = 0; while (cond) { __builtin_amdgcn_s_sleep(1); \
    if ((++_sp & 255u) == 0u) { if (xb_ld(&(bar)[XB_TMO])) break; if (_sp > XB_SPIN_CAP) { atomicAdd(&(bar)[XB_TMO], 1u); break; } } } } while (0)

struct XcdBarrier {
    unsigned* bar; unsigned x;
    volatile LAS unsigned* st;
};

__device__ __forceinline__ XcdBarrier xcd_barrier_post(unsigned* bar, volatile LAS unsigned* st) {
    XcdBarrier b; b.bar = bar; b.x = xb_xcc_id(); b.st = st;
    if (threadIdx.x == 0) (void)xb_add(&bar[XB_XCNT(b.x)], 1u);
    return b;
}
__device__ __forceinline__ void xcd_barrier_complete(unsigned* bar, unsigned x, unsigned& nloc, unsigned& nx) {
    const unsigned G = gridDim.x * gridDim.y * gridDim.z;
    unsigned sum, cnt, mine, sp = 0u;
    for (;;) {
        sum = 0u; cnt = 0u; mine = 0u;
#pragma unroll
        for (unsigned j = 0; j < 16; ++j) { const unsigned c = xb_ld(&bar[XB_XCNT(j)]); sum += c; cnt += (c > 0u) ? 1u : 0u; mine = (j == x) ? c : mine; }
        if (sum == G) break;
        __builtin_amdgcn_s_sleep(1);
        if ((++sp & 255u) == 0u) { if (xb_ld(&bar[XB_TMO])) break; if (sp > XB_SPIN_CAP) { atomicAdd(&bar[XB_TMO], 1u); break; } }
    }
    nloc = mine > 0u ? mine : 1u; nx = cnt > 0u ? cnt : 1u;
}

__device__ __forceinline__ void xcd_barrier(const XcdBarrier& b, const int wid  ) {
    asm volatile("s_waitcnt vmcnt(0)" ::: "memory");
    __syncthreads();
    if (wid == 0 && __builtin_amdgcn_mbcnt_hi(~0u, __builtin_amdgcn_mbcnt_lo(~0u, 0u)) == 0u) {
        unsigned* bar = b.bar;
        __builtin_amdgcn_s_waitcnt(0);
        unsigned nloc = b.st[0], nx = b.st[1];
        if (nloc == 0u) { xcd_barrier_complete(bar, b.x, nloc, nx); b.st[0] = nloc; b.st[1] = nx; }
        const unsigned old = xb_add(&bar[XB_XSUB(b.x)], 1u);
        const unsigned gen = old / nloc;
        if (old + 1u == (gen + 1u) * nloc) {
            __builtin_amdgcn_fence(__ATOMIC_RELEASE, "agent");
            asm volatile("s_waitcnt vmcnt(0)" ::: "memory");
            const unsigned og = xb_add(&bar[XB_TOP], 1u);
            const unsigned tg = og / nx;
            if (og + 1u == (tg + 1u) * nx) xb_add(&bar[XB_TOPGEN], 1u);
            else XB_SPIN(xb_ld(&bar[XB_TOPGEN]) == tg, bar);
            __builtin_amdgcn_fence(__ATOMIC_ACQUIRE, "agent");
            xb_add(&bar[XB_XGEN(b.x)], 1u);
            asm volatile("s_waitcnt vmcnt(0)" ::: "memory");
        } else {
            XB_SPIN(xb_ld(&bar[XB_XGEN(b.x)]) == gen, bar);
            __builtin_amdgcn_fence(__ATOMIC_ACQUIRE, "agent");
            asm volatile("s_waitcnt vmcnt(0)" ::: "memory");
        }
    }
    __syncthreads();
}

constexpr int NWAVES = 8;
constexpr int DM = 2048, DFF = 8192, NCTX = 4096, NLAT = 2048, MTOK = 6144;
constexpr int CSEQ = 256, LSEQ = 1024, PAST = 512, KVL = 1536;
constexpr int MODW = 6 * DM;
constexpr int MODL = 3 * MODW;
constexpr float ALPHA_F = 1.681792830507429f;
constexpr float LN_EPS = 1e-5f, RMS_EPS = 1e-6f;
constexpr int KSPLIT = 16;

constexpr size_t OUT_AK = 12582912, OUT_AV = 29360128, OUT_BK = 46137344, OUT_BV = 48234496, OUT_TOTAL = 50331648;

constexpr size_t MiB = 1u << 20;
constexpr size_t WS_CTL = 0, CTL_ZERO_BYTES = 1 * MiB;
constexpr size_t WS_MOD = 1 * MiB;
constexpr size_t WS_ROPE = 2 * MiB;
constexpr size_t WS_MODP = 4 * MiB;
constexpr size_t WS_WQKVA = 16 * MiB;
constexpr size_t WS_WOA = 64 * MiB;
constexpr size_t WS_WQKVB = 80 * MiB;
constexpr size_t WS_WOB = 92 * MiB;
constexpr size_t WS_WF = 100 * MiB;
constexpr size_t WS_DFTW = 108 * MiB;
constexpr size_t WS_DSCTX = 124 * MiB;
constexpr size_t WS_DSLAT = 126 * MiB;
constexpr size_t WS_WUP = 132 * MiB;
constexpr size_t WS_WDOWN = 260 * MiB;
constexpr size_t WS_KALLA = 388 * MiB;
constexpr size_t WS_VALLA = 412 * MiB;
constexpr size_t WS_KALLB = 436 * MiB;
constexpr size_t WS_VALLB = 440 * MiB;
constexpr size_t WS_X = 444 * MiB;
constexpr size_t WS_H = 492 * MiB;
constexpr size_t WS_U = 540 * MiB;
constexpr size_t WS_Q = 564 * MiB;
constexpr size_t WS_KCTX = 588 * MiB;
constexpr size_t WS_VCTX = 604 * MiB;
constexpr size_t WS_QKTMP = 620 * MiB;
constexpr size_t WS_ORAW = 680 * MiB;
constexpr size_t WS_OB = 776 * MiB;
constexpr size_t WS_HID = 800 * MiB;
constexpr size_t WS_ZCTX = 896 * MiB;
constexpr size_t WS_ZLAT = 928 * MiB;
constexpr size_t WS_END = 944 * MiB;

constexpr int CW_TMO = 0, CW_CODE = 1, CW_BAR = 4096;

constexpr int RING_OFF = 0, RING_BYTES = 131072;
constexpr int LDSCTL_OFF = RING_BYTES, MISC_OFF = LDSCTL_OFF + 320;
constexpr int LDS_BYTES = 147456;

struct Frame {
    LAS unsigned char* lds;
    volatile LAS unsigned* MISC;
    gu32* ctl;
    int wave, vcu, G;
    float* out;
    unsigned char* ws;
};
struct Args { const float* in[23]; float* out; unsigned char* ws; int ph_lo, ph_hi, li, pad; };
typedef __attribute__((address_space(4))) const Args CArgs;
__device__ __forceinline__ const float* in_ptr(int k) { CArgs* a = (CArgs*)__builtin_amdgcn_kernarg_segment_ptr(); asm volatile("" : "+s"(a)); return (const float*)(const GAS float*)a->in[k]; }
template <class T> __device__ __forceinline__ T* wsp(const Frame& F, size_t off) { GAS unsigned char* w = (GAS unsigned char*)F.ws; asm volatile("" : "+s"(w)); return (T*)(w + off); }
__device__ __forceinline__ int lane_id() { return (int)__builtin_amdgcn_mbcnt_hi(~0u, __builtin_amdgcn_mbcnt_lo(~0u, 0u)); }

__device__ __forceinline__ float wave_sum(float v) {
#pragma unroll
    for (int o = 1; o < 64; o <<= 1) v += __shfl_xor(v, o);
    return v;
}
__device__ __forceinline__ unsigned pkbf(float lo, float hi) { return pg8::cvt_pk_bf16(lo, hi); }

namespace att {
using bf16x8 = __attribute__((ext_vector_type(8))) short;
using s16x4  = __attribute__((ext_vector_type(4))) short;
using f32x16 = __attribute__((ext_vector_type(16))) float;
using u32x4  = __attribute__((ext_vector_type(4))) unsigned;
constexpr int D = 128, QBLK = 32, KVBLK = 64;
constexpr float SCALE = 0.088388347648318440f;
constexpr float THR = 8.f;
constexpr int SHM_V = KVBLK * D * 2, SHM_K = KVBLK * D * 2, SHM_ATTN = 2 * SHM_V + 2 * SHM_K + NWAVES * 64 * 4;
#define KSWZ(row, colB) ((row) * 256 + ((colB) ^ (((row) & 7) << 4)))
#define SBAR() __builtin_amdgcn_sched_barrier(0)
__device__ __forceinline__ int crow(int r, int hi) { return (r & 3) + 8 * (r >> 2) + 4 * hi; }
__device__ __forceinline__ unsigned cvtpk(float lo, float hi) { unsigned r; asm volatile("v_cvt_pk_bf16_f32 %0, %1, %2" : "=v"(r) : "v"(lo), "v"(hi)); return r; }

__device__ __forceinline__ void partialSM(f32x16& p0, f32x16& p1, float& m_reg, float& mn, float& alpha) {
  constexpr float C = SCALE * 1.4426950408889634f;
  float pmax = p0[0];
#pragma unroll
  for (int r = 1; r < 16; ++r) pmax = fmaxf(pmax, p0[r]);
#pragma unroll
  for (int r = 0; r < 16; ++r) pmax = fmaxf(pmax, p1[r]);
  { auto rr = __builtin_amdgcn_permlane32_swap(__float_as_uint(pmax), __float_as_uint(pmax), false, false);
    pmax = fmaxf(__uint_as_float(rr[0]), __uint_as_float(rr[1])); }
  if (__builtin_expect(__all(pmax - m_reg <= THR / SCALE), 1)) { mn = m_reg; alpha = 1.f; }
  else { mn = fmaxf(m_reg, pmax); alpha = __builtin_amdgcn_exp2f((m_reg - mn) * C); m_reg = mn; }
  float mnC = -mn * C;
#pragma unroll
  for (int r = 0; r < 16; ++r) p0[r] = fmaf(p0[r], C, mnC);
#pragma unroll
  for (int r = 0; r < 16; ++r) p1[r] = fmaf(p1[r], C, mnC);
#pragma unroll
  for (int r = 0; r < 16; ++r) p0[r] = __builtin_amdgcn_exp2f(p0[r]);
}
__device__ __forceinline__ void finishSM(f32x16& p0, f32x16& p1, float alpha, float& l_reg, bf16x8& pa0, bf16x8& pa1, bf16x8& pa2, bf16x8& pa3) {
#pragma unroll
  for (int r = 0; r < 16; ++r) p1[r] = __builtin_amdgcn_exp2f(p1[r]);
  float ps = 0;
#pragma unroll
  for (int r = 0; r < 16; ++r) ps += p0[r];
#pragma unroll
  for (int r = 0; r < 16; ++r) ps += p1[r];
  { auto rr = __builtin_amdgcn_permlane32_swap(__float_as_uint(ps), __float_as_uint(ps), false, false);
    ps = __uint_as_float(rr[0]) + __uint_as_float(rr[1]); }
  l_reg = l_reg * alpha + ps;
#define PK4(P, BASE, OUT) do { unsigned a0 = cvtpk(P[BASE + 0], P[BASE + 1]), a1 = cvtpk(P[BASE + 2], P[BASE + 3]);   \
    unsigned b0 = cvtpk(P[BASE + 4], P[BASE + 5]), b1 = cvtpk(P[BASE + 6], P[BASE + 7]);                              \
    auto r0 = __builtin_amdgcn_permlane32_swap(a0, b0, false, false); auto r1 = __builtin_amdgcn_permlane32_swap(a1, b1, false, false); \
    u32x4 w = {r0[0], r1[0], r0[1], r1[1]}; OUT = *reinterpret_cast<bf16x8*>(&w); } while (0)
  PK4(p0, 0, pa0); PK4(p0, 8, pa1); PK4(p1, 0, pa2); PK4(p1, 8, pa3);
#undef PK4
}
__device__ __forceinline__ void qkt(f32x16& p0, f32x16& p1, const LAS unsigned char* Ks, const bf16x8* qr, int r32, int hi) {
  p0 = f32x16{}; p1 = f32x16{};
#pragma unroll
  for (int d0 = 0; d0 < 8; ++d0) { int cb = (d0 * 16 + hi * 8) * 2;
    bf16x8 b0 = *reinterpret_cast<const LAS bf16x8*>(Ks + KSWZ(r32, cb));
    bf16x8 b1 = *reinterpret_cast<const LAS bf16x8*>(Ks + KSWZ(32 + r32, cb));
    p0 = __builtin_amdgcn_mfma_f32_32x32x16_bf16(b0, qr[d0], p0, 0, 0, 0);
    p1 = __builtin_amdgcn_mfma_f32_32x32x16_bf16(b1, qr[d0], p1, 0, 0, 0); }
}
__device__ __forceinline__ int v_st(int k, int c) { const int kk = (k & ~0xC) | ((k & 4) << 1) | ((k & 8) >> 1); return ((kk >> 3) * 4 + (c >> 5)) * 512 + ((kk & 7) * 32 + (c & 31)) * 2; }
__device__ __forceinline__ int v_rd_base(int lane) { return ((lane & 3) << 3) | (((lane >> 2) & 3) << 6) | (((lane >> 4) & 1) << 5) | (((lane >> 5) & 1) << 8); }
constexpr int v_rd_off(int d0, int ks, int half) { return d0 * 512 + ks * 4096 + half * 2048; }
template <int OFF> __device__ __forceinline__ s16x4 tr_read(int vb) {
  s16x4 r; asm volatile("ds_read_b64_tr_b16 %0, %1 offset:%2" : "=&v"(r) : "v"(vb), "i"(OFF) : "memory"); return r;
}
template <int D0> __device__ __forceinline__ void pv_one(f32x16& od, int vb, bf16x8 pa0, bf16x8 pa1, bf16x8 pa2, bf16x8 pa3) {
  const s16x4 l0 = tr_read<v_rd_off(D0, 0, 0)>(vb), h0 = tr_read<v_rd_off(D0, 0, 1)>(vb), l1 = tr_read<v_rd_off(D0, 1, 0)>(vb), h1 = tr_read<v_rd_off(D0, 1, 1)>(vb);
  const s16x4 l2 = tr_read<v_rd_off(D0, 2, 0)>(vb), h2 = tr_read<v_rd_off(D0, 2, 1)>(vb), l3 = tr_read<v_rd_off(D0, 3, 0)>(vb), h3 = tr_read<v_rd_off(D0, 3, 1)>(vb);
  asm volatile("s_waitcnt lgkmcnt(0)" ::: "memory"); SBAR();
#define PK(L, H) (bf16x8){L[0], L[1], L[2], L[3], H[0], H[1], H[2], H[3]}
  od = __builtin_amdgcn_mfma_f32_32x32x16_bf16(pa0, PK(l0, h0), od, 0, 0, 0);
  od = __builtin_amdgcn_mfma_f32_32x32x16_bf16(pa1, PK(l1, h1), od, 0, 0, 0);
  od = __builtin_amdgcn_mfma_f32_32x32x16_bf16(pa2, PK(l2, h2), od, 0, 0, 0);
  od = __builtin_amdgcn_mfma_f32_32x32x16_bf16(pa3, PK(l3, h3), od, 0, 0, 0);
#undef PK
}
__device__ __forceinline__ void pv_d0(f32x16* o, int vb, bf16x8 pa0, bf16x8 pa1, bf16x8 pa2, bf16x8 pa3) {
  pv_one<0>(o[0], vb, pa0, pa1, pa2, pa3); pv_one<1>(o[1], vb, pa0, pa1, pa2, pa3); pv_one<2>(o[2], vb, pa0, pa1, pa2, pa3); pv_one<3>(o[3], vb, pa0, pa1, pa2, pa3);
}
template <int LDQ, int LDK, int LDO, bool OF32>
__device__ __forceinline__ void attn_body(const unsigned short* __restrict__ Qb, const unsigned short* __restrict__ Kh, const unsigned short* __restrict__ Vh,
                                          void* __restrict__ Ob, int seq, LAS unsigned char* lds, const int wid  ) {
  const int lane = lane_id(), tid = wid * 64 + lane, r32 = lane & 31, hi = lane >> 5;
  LAS unsigned char* V_lds = lds; LAS unsigned char* K_lds = lds + 2 * SHM_V;
  LAS float* ws = (LAS float*)(lds + 2 * SHM_V + 2 * SHM_K) + wid * 64; LAS float* li_l = ws; LAS float* al_l = ws + 32;
  float m_reg = -1e30f, l_reg = 0; f32x16 o[4] = {}; bf16x8 qr[8];
  { const unsigned qoff = (unsigned)(((wid * QBLK + r32) * LDQ + hi * 8) * 2);
#pragma unroll
    for (int d0 = 0; d0 < 8; ++d0) qr[d0] = *reinterpret_cast<const bf16x8*>((const char*)Qb + qoff + d0 * 32); }
  const int sr = tid >> 4, sc = (tid & 15) * 8, vst0 = v_st(sr, sc), vst1 = v_st(32 + sr, sc);
  const int vb0 = (int)(unsigned)(uintptr_t)V_lds + v_rd_base(lane);
  const unsigned voff = (unsigned)((sr * LDK + sc) * 2);
  struct { bf16x8 vs0, vs1, ks0, ks1; } sr_[2];
#define SLOAD(i, k0) do { const char* vb_ = (const char*)Vh + (size_t)(k0) * (LDK * 2); const char* kb_ = (const char*)Kh + (size_t)(k0) * (LDK * 2); \
    sr_[i].vs0 = *reinterpret_cast<const bf16x8*>(vb_ + voff); sr_[i].vs1 = *reinterpret_cast<const bf16x8*>(vb_ + 32 * LDK * 2 + voff); \
    sr_[i].ks0 = *reinterpret_cast<const bf16x8*>(kb_ + voff); sr_[i].ks1 = *reinterpret_cast<const bf16x8*>(kb_ + 32 * LDK * 2 + voff); } while (0)
#define SWRITE(b, i) do { *(LAS bf16x8*)(V_lds + (b) * SHM_V + vst0) = sr_[i].vs0;          \
    *(LAS bf16x8*)(V_lds + (b) * SHM_V + vst1) = sr_[i].vs1; int kc = sc * 2;               \
    *(LAS bf16x8*)(K_lds + (b) * SHM_K + KSWZ(sr, kc)) = sr_[i].ks0;                       \
    *(LAS bf16x8*)(K_lds + (b) * SHM_K + KSWZ(32 + sr, kc)) = sr_[i].ks1; } while (0)
#define SWAIT() asm volatile("s_waitcnt vmcnt(4)" ::: "memory")
#define RESC(a) do { if (__any((a) < 1.f)) { if (hi == 0) al_l[r32] = (a); asm volatile("s_waitcnt lgkmcnt(0)" ::: "memory"); \
    _Pragma("unroll") for (int d = 0; d < 4; ++d) _Pragma("unroll") for (int r = 0; r < 16; ++r) o[d][r] *= al_l[crow(r, hi)]; } } while (0)
  f32x16 pA0, pA1, pB0, pB1; float mnA, mnB, alA, alB; bf16x8 pa0, pa1, pa2, pa3; const int NT = seq / KVBLK;
  constexpr int SE = 0, SO = 1;
  SLOAD(SE, 0); asm volatile("s_waitcnt vmcnt(0)" ::: "memory"); SWRITE(0, SE); __syncthreads();
  qkt(pA0, pA1, K_lds, qr, r32, hi); partialSM(pA0, pA1, m_reg, mnA, alA);
  SLOAD(SO, KVBLK); if (2 < NT) SLOAD(SE, 2 * KVBLK);
  SWAIT(); SWRITE(1, SO); __syncthreads();
  for (int j = 1; j + 1 < NT; j += 2) {
    SBAR(); qkt(pB0, pB1, K_lds + SHM_K, qr, r32, hi);
    finishSM(pA0, pA1, alA, l_reg, pa0, pa1, pa2, pa3); SBAR();
    SLOAD(SO, (j + 2) * KVBLK); SBAR();
    pv_d0(o, vb0, pa0, pa1, pa2, pa3); partialSM(pB0, pB1, m_reg, mnB, alB);
    __syncthreads(); SWAIT(); SWRITE(0, SE);
    RESC(alB); __syncthreads();
    SBAR(); qkt(pA0, pA1, K_lds, qr, r32, hi);
    finishSM(pB0, pB1, alB, l_reg, pa0, pa1, pa2, pa3); SBAR();
    if (j + 3 < NT) SLOAD(SE, (j + 3) * KVBLK); SBAR();
    pv_d0(o, vb0 + SHM_V, pa0, pa1, pa2, pa3); partialSM(pA0, pA1, m_reg, mnA, alA);
    __syncthreads(); SWAIT(); SWRITE(1, SO);
    RESC(alA); __syncthreads();
  }
  SBAR(); qkt(pB0, pB1, K_lds + SHM_K, qr, r32, hi);
  finishSM(pA0, pA1, alA, l_reg, pa0, pa1, pa2, pa3); SBAR();
  pv_d0(o, vb0, pa0, pa1, pa2, pa3); partialSM(pB0, pB1, m_reg, mnB, alB);
  __syncthreads(); RESC(alB);
  finishSM(pB0, pB1, alB, l_reg, pa0, pa1, pa2, pa3); SBAR();
  pv_d0(o, vb0 + SHM_V, pa0, pa1, pa2, pa3);
  if (hi == 0) li_l[r32] = l_reg; asm volatile("s_waitcnt lgkmcnt(0)" ::: "memory");
  float rli[16];
#pragma unroll
  for (int r = 0; r < 16; ++r) rli[r] = __builtin_amdgcn_rcpf(li_l[crow(r, hi)]);
  int lane_o = lane; asm volatile("" : "+v"(lane_o));
  const int r32o = lane_o & 31, hio = lane_o >> 5;
  if constexpr (OF32) {
    char* Ow = (char*)Ob + (size_t)(wid * QBLK) * (LDO * 4);
#pragma unroll
    for (int r = 0; r < 16; ++r) { const unsigned ooff = (unsigned)((crow(r, hio) * LDO + r32o) * 4);
#pragma unroll
      for (int d0 = 0; d0 < 4; ++d0) *(float*)(Ow + ooff + d0 * 128) = o[d0][r] * rli[r]; }
  } else {
    char* Ow = (char*)Ob + (size_t)(wid * QBLK) * (LDO * 2);
#pragma unroll
    for (int r = 0; r < 16; ++r) { const unsigned ooff = (unsigned)((crow(r, hio) * LDO + r32o) * 2);
#pragma unroll
      for (int d0 = 0; d0 < 4; ++d0) *(unsigned short*)(Ow + ooff + d0 * 64) = (unsigned short)(cvtpk(o[d0][r] * rli[r], 0.f) & 0xffffu); }
  }
  __syncthreads();
#undef SLOAD
#undef SWRITE
#undef SWAIT
#undef RESC
}
#undef KSWZ
#undef SBAR
}

struct RouterQkvA {
    unsigned short *Q, *Kctx, *Vctx, *Vall; float *QKtmp, *outK, *outV;
    __device__ __forceinline__ pg8::Route operator()(const pg8::Unit& u) const {
        pg8::Route rt; rt.ob = nullptr; rt.of = nullptr; rt.ldb = DM; rt.ldf = DM;
        const int sect = u.pn >> 3, col0 = (u.pn & 7) * 256;
        if (u.pm < 16) { const size_t rb = (size_t)u.pm * 256;
            if (sect == 0) rt.ob = Q + rb * DM + col0;
            else if (sect == 1) { rt.ob = Kctx + rb * DM + col0; rt.of = outK + (size_t)u.pm * (2 * 256 * DM) + col0; }
            else { rt.ob = Vctx + rb * DM + col0; rt.of = outV + (size_t)u.pm * (2 * 256 * DM) + col0; }
        } else { const int lt = u.pm - 16, b = lt >> 2, s0 = (lt & 3) * 256;
            if (sect == 0) { rt.of = QKtmp + (size_t)lt * 256 * 4096 + col0; rt.ldf = 4096; }
            else if (sect == 1) { rt.of = QKtmp + (size_t)lt * 256 * 4096 + 2048 + col0; rt.ldf = 4096; }
            else rt.ob = Vall + ((size_t)b * KVL + PAST + s0) * DM + col0;
        }
        return rt;
    }
};
struct RouterQkvB {
    unsigned short *Vctx, *Vall; float *QKtmp, *outV;
    __device__ __forceinline__ pg8::Route operator()(const pg8::Unit& u) const {
        pg8::Route rt; rt.ob = nullptr; rt.of = nullptr; rt.ldb = 512; rt.ldf = 2560;
        const size_t rb = (size_t)u.pm * 256;
        if (u.pn < 10) { rt.of = QKtmp + rb * 2560 + u.pn * 256; }
        else { const int c0 = (u.pn - 10) * 256;
            if (u.pm < 16) { rt.ob = Vctx + rb * 512 + c0; rt.of = outV + rb * 512 + c0; rt.ldf = 512; }
            else { const int lt = u.pm - 16, b = lt >> 2, s0 = (lt & 3) * 256; rt.ob = Vall + ((size_t)b * KVL + PAST + s0) * 512 + c0; }
        }
        return rt;
    }
};
struct RouterDft1 {
    unsigned short *Zctx, *Zlat;
    __device__ __forceinline__ pg8::Route operator()(const pg8::Unit& u) const {
        pg8::Route rt; rt.of = nullptr; rt.ldf = 0;
        const int part = u.pm >> 3, col0 = (u.pm & 7) * 256;
        if (u.pn < 16) { rt.ob = Zctx + ((size_t)u.pn * DM + col0) * 512 + part * 256; rt.ldb = 512; }
        else { const int lt = u.pn - 16, b = lt >> 2, p0 = (lt & 3) * 256; rt.ob = Zlat + ((size_t)b * DM + col0) * 2048 + part * 1024 + p0; rt.ldb = 2048; }
        return rt;
    }
};
struct RouterDft2Ctx {
    unsigned short* Y;
    __device__ __forceinline__ pg8::Route operator()(const pg8::Unit& u) const {
        pg8::Route rt; rt.of = nullptr; rt.ldf = 0; rt.ldb = DM;
        const int b = u.pn >> 3, col0 = (u.pn & 7) * 256; rt.ob = Y + (size_t)(b * 256) * DM + col0; return rt;
    }
};
struct RouterDft2Lat {
    unsigned short* Y;
    __device__ __forceinline__ pg8::Route operator()(const pg8::Unit& u) const {
        pg8::Route rt; rt.of = nullptr; rt.ldf = 0; rt.ldb = DM;
        const int b = u.pn >> 3, col0 = (u.pn & 7) * 256; rt.ob = Y + (size_t)(NCTX + b * LSEQ + u.pm * 256) * DM + col0; return rt;
    }
};

__device__ __forceinline__ void p0_transpose_item(const float* W, int K, int N, unsigned short* WT, LAS float* scr, int item, int lane) {
    const int nblk = N / 32, kb = item / nblk, nb = item % nblk, k0 = 64 * kb, n0 = 32 * nb;
#pragma unroll 8
    for (int i = 0; i < 32; ++i) { const int kk = 2 * i + (lane >> 5); scr[kk * 33 + (lane & 31)] = W[(size_t)(k0 + kk) * N + n0 + (lane & 31)]; }
    LDS_WAIT(); asm volatile("" ::: "memory");
    const int c = lane & 7;
#pragma unroll
    for (int j = 0; j < 4; ++j) { const int n = (lane >> 3) + 8 * j; const LAS float* s = scr + (8 * c) * 33 + n;
        v4u o; o.x = pkbf(s[0 * 33], s[1 * 33]); o.y = pkbf(s[2 * 33], s[3 * 33]); o.z = pkbf(s[4 * 33], s[5 * 33]); o.w = pkbf(s[6 * 33], s[7 * 33]);
        *(GAS v4u*)(WT + (size_t)(n0 + n) * K + k0 + 8 * c) = o; }
    LDS_WAIT(); asm volatile("" ::: "memory");
}
__device__ __forceinline__ void cvt_row(const float* src, unsigned short* dst, int n, int lane) {
    for (int i = lane * 8; i < n; i += 512) { const f32x4 a = *(const f32x4*)(src + i), b = *(const f32x4*)(src + i + 4);
        v4u o; o.x = pkbf(a.x, a.y); o.y = pkbf(a.z, a.w); o.z = pkbf(b.x, b.y); o.w = pkbf(b.z, b.w); *(v4u*)(dst + i) = o; }
}
__device__ __forceinline__ float dftw_val(int j, int c) {
    const int part = j >> 11, col = j & 2047, g = col >> 9, ko = col & 511, gin = c >> 9, n = c & 511;
    if (gin != g) return 0.f;
    const float x = (float)((ko * n) & 511) * (1.0f / 256.0f);
    return (part ? sinpif(x) : cospif(x)) * 0.04419417382415922f;
}
__device__ __forceinline__ float dsctx_val(int pos, int kk) {
    const int k = kk & 255; const float x = (float)((pos * k) & 255) * (1.0f / 128.0f);
    return (kk < 256 ? cospif(x) : -sinpif(x)) * 0.0625f;
}
__device__ __forceinline__ float dslat_val(int pos, int kk) {
    const int k = kk & 1023; const float x = (float)((pos * k) & 1023) * (1.0f / 512.0f);
    return (kk < 1024 ? cospif(x) : -sinpif(x)) * 0.03125f;
}
__device__ __forceinline__ float silu_f(float x) { return x / (1.0f + __expf(-x)); }

__device__ __forceinline__ void p0_prologue(Frame& F) {
    LAS float* scr = (LAS float*)(F.lds + RING_OFF + F.wave * 16384);
    const int gw = F.vcu * NWAVES + F.wave, NGW = F.G * NWAVES, lane = lane_id();
    constexpr int I_QA = 32 * 192, I_OA = 32 * 64, I_QB = 32 * 96, I_UP = 32 * 256, I_DN = 128 * 64;
    constexpr int NITEMS = 2 * I_QA + 2 * I_OA + I_QB + 2 * I_OA + 4 * I_UP + 4 * I_DN;
    for (int it = gw; it < NITEMS; it += NGW) {
        int r = it;
        if (r < 2 * I_QA) { const int j = r / I_QA; p0_transpose_item(in_ptr(14) + (size_t)j * DM * 6144, DM, 6144, wsp<unsigned short>(F, WS_WQKVA) + (size_t)j * 6144 * DM, scr, r % I_QA, lane); continue; } r -= 2 * I_QA;
        if (r < 2 * I_OA) { const int j = r / I_OA; p0_transpose_item(in_ptr(15) + (size_t)j * DM * DM, DM, DM, wsp<unsigned short>(F, WS_WOA) + (size_t)j * DM * DM, scr, r % I_OA, lane); continue; } r -= 2 * I_OA;
        if (r < I_QB) { p0_transpose_item(in_ptr(18), DM, 3072, wsp<unsigned short>(F, WS_WQKVB), scr, r, lane); continue; } r -= I_QB;
        if (r < I_OA) { p0_transpose_item(in_ptr(19), DM, DM, wsp<unsigned short>(F, WS_WOB), scr, r, lane); continue; } r -= I_OA;
        if (r < I_OA) { p0_transpose_item(in_ptr(22), DM, DM, wsp<unsigned short>(F, WS_WF), scr, r, lane); continue; } r -= I_OA;
        if (r < 4 * I_UP) { const int l = r / I_UP; p0_transpose_item(in_ptr(12) + (size_t)l * DM * DFF, DM, DFF, wsp<unsigned short>(F, WS_WUP) + (size_t)l * DFF * DM, scr, r % I_UP, lane); continue; } r -= 4 * I_UP;
        { const int l = r / I_DN; p0_transpose_item(in_ptr(13) + (size_t)l * DFF * DM, DFF, DM, wsp<unsigned short>(F, WS_WDOWN) + (size_t)l * DM * DFF, scr, r % I_DN, lane); }
    }
    for (int it = gw; it < 6144; it += NGW) {
        if (it < 4096) { const int isv = it >> 11, r = it & 2047, b = r >> 10, j = (r >> 9) & 1, t = r & 511;
            cvt_row((isv ? in_ptr(3) : in_ptr(2)) + (size_t)r * DM, wsp<unsigned short>(F, isv ? WS_VALLA : WS_KALLA) + ((size_t)(j * 2 + b) * KVL + t) * DM, DM, lane); }
        else { const int q = it - 4096, isv = q >> 10, r = q & 1023, b = r >> 9, t = r & 511;
            cvt_row((isv ? in_ptr(5) : in_ptr(4)) + (size_t)r * 512, wsp<unsigned short>(F, isv ? WS_VALLB : WS_KALLB) + ((size_t)b * KVL + t) * 512, 512, lane); }
    }
    for (int it = gw; it < 4096 + 256 + 1024; it += NGW) {
        if (it < 4096) { unsigned short* d = wsp<unsigned short>(F, WS_DFTW) + (size_t)it * DM;
            for (int c0 = lane * 8; c0 < DM; c0 += 512) { v4u o; o.x = pkbf(dftw_val(it, c0), dftw_val(it, c0 + 1)); o.y = pkbf(dftw_val(it, c0 + 2), dftw_val(it, c0 + 3)); o.z = pkbf(dftw_val(it, c0 + 4), dftw_val(it, c0 + 5)); o.w = pkbf(dftw_val(it, c0 + 6), dftw_val(it, c0 + 7)); *(v4u*)(d + c0) = o; } }
        else if (it < 4096 + 256) { const int pos = it - 4096; unsigned short* d = wsp<unsigned short>(F, WS_DSCTX) + (size_t)pos * 512;
            { const int c0 = lane * 8; v4u o; o.x = pkbf(dsctx_val(pos, c0), dsctx_val(pos, c0 + 1)); o.y = pkbf(dsctx_val(pos, c0 + 2), dsctx_val(pos, c0 + 3)); o.z = pkbf(dsctx_val(pos, c0 + 4), dsctx_val(pos, c0 + 5)); o.w = pkbf(dsctx_val(pos, c0 + 6), dsctx_val(pos, c0 + 7)); *(v4u*)(d + c0) = o; } }
        else { const int pos = it - 4096 - 256; unsigned short* d = wsp<unsigned short>(F, WS_DSLAT) + (size_t)pos * 2048;
            for (int c0 = lane * 8; c0 < 2048; c0 += 512) { v4u o; o.x = pkbf(dslat_val(pos, c0), dslat_val(pos, c0 + 1)); o.y = pkbf(dslat_val(pos, c0 + 2), dslat_val(pos, c0 + 3)); o.z = pkbf(dslat_val(pos, c0 + 4), dslat_val(pos, c0 + 5)); o.w = pkbf(dslat_val(pos, c0 + 6), dslat_val(pos, c0 + 7)); *(v4u*)(d + c0) = o; } }
    }
    for (int it = gw; it < 32; it += NGW) { const int e = it * 64 + lane, pos = e >> 5, f = e & 31;
        const float inv = powf(10000.0f, -(float)f / 32.0f), ang = (float)pos * inv;
        float* d = wsp<float>(F, WS_ROPE) + 2 * e; d[0] = cosf(ang); d[1] = sinf(ang); }
    for (int it = gw; it < 4 * 48 * KSPLIT; it += NGW) {
        const int l = it / (48 * KSPLIT), rem = it % (48 * KSPLIT), cc = rem / KSPLIT, kc = rem % KSPLIT;
        const int col = cc * 256 + lane * 4, k0 = kc * (DM / KSPLIT);
        float sv[3][2];
#pragma unroll
        for (int r = 0; r < 3; ++r) { const float* cp = (r == 0) ? in_ptr(7) : in_ptr(6) + (size_t)(r - 1) * DM;
#pragma unroll
            for (int hh = 0; hh < 2; ++hh) sv[r][hh] = silu_f(cp[k0 + hh * 64 + lane]); }
        f32x4 acc[3] = {{0.f, 0.f, 0.f, 0.f}, {0.f, 0.f, 0.f, 0.f}, {0.f, 0.f, 0.f, 0.f}};
        const float* wp = in_ptr(8) + ((size_t)l * DM + k0) * MODW + col;
#pragma unroll
        for (int hh = 0; hh < 2; ++hh) {
#pragma unroll 8
            for (int kk = 0; kk < 64; ++kk) { const f32x4 w = *(const f32x4*)(wp + (size_t)(hh * 64 + kk) * MODW);
#pragma unroll
                for (int r = 0; r < 3; ++r) { const float s = __uint_as_float(__builtin_amdgcn_readlane(__float_as_uint(sv[r][hh]), kk)); acc[r] += w * s; } } }
        float* dp = wsp<float>(F, WS_MODP) + ((size_t)(kc * 4 + l) * 3) * MODW + col;
#pragma unroll
        for (int r = 0; r < 3; ++r) *(f32x4*)(dp + (size_t)r * MODW) = acc[r];
    }
}
__device__ __forceinline__ void p_mod_reduce(Frame& F) {
    const int gt = (F.vcu * NWAVES + F.wave) * 64 + lane_id(), NT = F.G * NWAVES * 64;
    for (int i = gt; i < 4 * 3 * (MODW / 4); i += NT) { const int l = i / (3 * (MODW / 4)), rem = i % (3 * (MODW / 4)), r = rem / (MODW / 4), c4 = rem % (MODW / 4);
        f32x4 s = *(const f32x4*)(in_ptr(9) + (size_t)l * MODW + c4 * 4);
#pragma unroll
        for (int kc = 0; kc < KSPLIT; ++kc) s += *(const f32x4*)(wsp<float>(F, WS_MODP) + ((size_t)(kc * 4 + l) * 3 + r) * MODW + c4 * 4);
        *(f32x4*)(wsp<float>(F, WS_MOD) + ((size_t)l * 3 + r) * MODW + c4 * 4) = s; }
}
__device__ __forceinline__ int cond_of_row(int row) { return row < NCTX ? 0 : 1 + ((row - NCTX) >> 10); }
__device__ __forceinline__ void p_modulate0(Frame& F) {
    const int gw = F.vcu * NWAVES + F.wave, NGW = F.G * NWAVES, lane = lane_id();
    for (int row = gw; row < MTOK; row += NGW) {
        const float* xp = row < NCTX ? in_ptr(0) + (size_t)row * DM : in_ptr(1) + (size_t)(row - NCTX) * DM;
        const float* md = wsp<float>(F, WS_MOD) + (size_t)cond_of_row(row) * MODW;
        float* xo = wsp<float>(F, WS_X) + (size_t)row * DM; unsigned short* uo = wsp<unsigned short>(F, WS_U) + (size_t)row * DM;
#pragma unroll
        for (int j = 0; j < 8; ++j) { const int c = 4 * lane + 256 * j; const f32x4 x = *(const f32x4*)(xp + c), sh = *(const f32x4*)(md + c), sc = *(const f32x4*)(md + DM + c);
            *(f32x4*)(xo + c) = x; const f32x4 u = x * (sc + 1.0f) + sh;
            *(unsigned long long*)(uo + c) = (unsigned long long)pkbf(u.x, u.y) | ((unsigned long long)pkbf(u.z, u.w) << 32); }
    }
}
__device__ __forceinline__ void p_layernorm(Frame& F, const float* g, const float* bta, float* xout, const float* mdn, int shi, int sci) {
    const int gw = F.vcu * NWAVES + F.wave, NGW = F.G * NWAVES, lane = lane_id();
    for (int row = gw; row < MTOK; row += NGW) {
        const float* hp = wsp<float>(F, WS_H) + (size_t)row * DM;
        f32x4 v[8]; float s = 0.f;
#pragma unroll
        for (int j = 0; j < 8; ++j) { v[j] = *(const f32x4*)(hp + 4 * lane + 256 * j); s += (v[j].x + v[j].y) + (v[j].z + v[j].w); }
        const float mean = wave_sum(s) * (1.0f / DM); float q = 0.f;
#pragma unroll
        for (int j = 0; j < 8; ++j) { v[j] = v[j] - mean; q += (v[j].x * v[j].x + v[j].y * v[j].y) + (v[j].z * v[j].z + v[j].w * v[j].w); }
        const float rstd = 1.0f / sqrtf(wave_sum(q) * (1.0f / DM) + LN_EPS);
        float* xo = xout + (size_t)row * DM; unsigned short* uo = wsp<unsigned short>(F, WS_U) + (size_t)row * DM;
        const float* md = mdn ? mdn + (size_t)cond_of_row(row) * MODW : nullptr;
#pragma unroll
        for (int j = 0; j < 8; ++j) { const int c = 4 * lane + 256 * j; const f32x4 y = v[j] * rstd * *(const f32x4*)(g + c) + *(const f32x4*)(bta + c);
            *(f32x4*)(xo + c) = y;
            if (md) { const f32x4 u = y * (*(const f32x4*)(md + sci * DM + c) + 1.0f) + *(const f32x4*)(md + shi * DM + c);
                *(unsigned long long*)(uo + c) = (unsigned long long)pkbf(u.x, u.y) | ((unsigned long long)pkbf(u.z, u.w) << 32); } }
    }
}
__device__ __forceinline__ unsigned short bf1(float x) { return (unsigned short)(pkbf(x, 0.f) & 0xffffu); }
__device__ __forceinline__ void p_rope_a(Frame& F, unsigned short* Kall) {
    const int gw = F.vcu * NWAVES + F.wave, NGW = F.G * NWAVES, lane = lane_id(), axis = lane >> 5, f = lane & 31;
    for (int lr = gw; lr < NLAT; lr += NGW) { const int b = lr >> 10, s = lr & 1023, pos = axis ? (s & 63) : (s >> 6);
        const float cs = wsp<float>(F, WS_ROPE)[2 * (pos * 32 + f)], sn = wsp<float>(F, WS_ROPE)[2 * (pos * 32 + f) + 1];
        const float* src = wsp<float>(F, WS_QKTMP) + (size_t)lr * 4096 + axis * 64 + f;
        unsigned short* qd = wsp<unsigned short>(F, WS_Q) + (size_t)(NCTX + lr) * DM + axis * 64 + f;
        unsigned short* kd = Kall + ((size_t)b * KVL + PAST + s) * DM + axis * 64 + f;
#pragma unroll 8
        for (int c = 0; c < 32; ++c) { const float x1 = src[c * 128], x2 = src[c * 128 + 32]; const float o1 = x1 * cs - x2 * sn, o2 = x1 * sn + x2 * cs;
            unsigned short* d = c < 16 ? qd + c * 128 : kd + (c - 16) * 128; d[0] = bf1(o1); d[32] = bf1(o2); }
    }
}
__device__ __forceinline__ void p_norm_rope_b(Frame& F) {
    const int gw = F.vcu * NWAVES + F.wave, NGW = F.G * NWAVES, lane = lane_id(), axis = lane >> 5, f = lane & 31, dd = axis * 64 + f;
    const float gq1 = in_ptr(20)[dd], gq2 = in_ptr(20)[dd + 32], gk1 = in_ptr(21)[dd], gk2 = in_ptr(21)[dd + 32];
    for (int row = gw; row < MTOK; row += NGW) { const bool lat = row >= NCTX; const int lr = row - NCTX, b = lr >> 10, s = lr & 1023, pos = axis ? (s & 63) : (s >> 6);
        float cs = 1.f, sn = 0.f; if (lat) { cs = wsp<float>(F, WS_ROPE)[2 * (pos * 32 + f)]; sn = wsp<float>(F, WS_ROPE)[2 * (pos * 32 + f) + 1]; }
        const float* src = wsp<float>(F, WS_QKTMP) + (size_t)row * 2560 + dd;
        unsigned short* qd = wsp<unsigned short>(F, WS_Q) + (size_t)row * DM + dd;
#pragma unroll 4
        for (int c = 0; c < 20; ++c) { float x1 = src[c * 128], x2 = src[c * 128 + 32];
            const float rs = 1.0f / sqrtf(wave_sum(x1 * x1 + x2 * x2) * (1.0f / 128.0f) + RMS_EPS);
            x1 *= rs * (c < 16 ? gq1 : gk1); x2 *= rs * (c < 16 ? gq2 : gk2);
            const float o1 = x1 * cs - x2 * sn, o2 = x1 * sn + x2 * cs;
            if (c < 16) { qd[c * 128] = bf1(o1); qd[c * 128 + 32] = bf1(o2); }
            else { const int kh = c - 16;
                if (!lat) { unsigned short* kd = wsp<unsigned short>(F, WS_KCTX) + (size_t)row * 512 + kh * 128 + dd; kd[0] = bf1(o1); kd[32] = bf1(o2);
                    float* ko = F.out + OUT_BK + (size_t)row * 512 + kh * 128 + dd; ko[0] = o1; ko[32] = o2; }
                else { unsigned short* kd = wsp<unsigned short>(F, WS_KALLB) + ((size_t)b * KVL + PAST + s) * 512 + kh * 128 + dd; kd[0] = bf1(o1); kd[32] = bf1(o2); } } }
    }
}
__device__ __forceinline__ void p_combine_a(Frame& F, int j, float lam_init) {
    const int gw = F.vcu * NWAVES + F.wave, NGW = F.G * NWAVES, lane = lane_id();
    const float* lp = in_ptr(16) + (size_t)j * 512;
    const float s1 = wave_sum(lp[lane] * lp[128 + lane] + lp[64 + lane] * lp[192 + lane]), s2 = wave_sum(lp[256 + lane] * lp[384 + lane] + lp[320 + lane] * lp[448 + lane]);
    const float lam = expf(s1) - expf(s2) + lam_init;
    const f32x4 g = *(const f32x4*)(in_ptr(17) + (size_t)j * 256 + 4 * lane) * (1.0f - lam_init);
    for (int row = gw; row < MTOK; row += NGW) { const float* op = wsp<float>(F, WS_ORAW) + (size_t)row * 4096 + 4 * lane; unsigned short* od = wsp<unsigned short>(F, WS_OB) + (size_t)row * DM + 4 * lane;
#pragma unroll
        for (int h = 0; h < 8; ++h) { const f32x4 o0 = *(const f32x4*)(op + h * 512), o1 = *(const f32x4*)(op + h * 512 + 256); const f32x4 o = o0 - o1 * lam;
            const float rs = 1.0f / sqrtf(wave_sum((o.x * o.x + o.y * o.y) + (o.z * o.z + o.w * o.w)) * (1.0f / 256.0f) + RMS_EPS);
            const f32x4 y = o * rs * g;
            *(unsigned long long*)(od + h * 256) = (unsigned long long)pkbf(y.x, y.y) | ((unsigned long long)pkbf(y.z, y.w) << 32); }
    }
}
__device__ __forceinline__ void p_attn_a(Frame& F, int j) {
    const unsigned short* Q = wsp<unsigned short>(F, WS_Q); const unsigned short* Kc = wsp<unsigned short>(F, WS_KCTX); const unsigned short* Vc = wsp<unsigned short>(F, WS_VCTX);
    const unsigned short* Ka = wsp<unsigned short>(F, WS_KALLA) + (size_t)j * 2 * KVL * DM; const unsigned short* Va = wsp<unsigned short>(F, WS_VALLA) + (size_t)j * 2 * KVL * DM;
    float* O = wsp<float>(F, WS_ORAW);
    for (int it = F.vcu; it < 768; it += F.G) {
        const unsigned short *q, *k, *v; float* o; int seq;
        if (it < 256) { const int u = it, vh = u & 1, p = (u >> 1) & 1, qb = (u >> 2) & 3, h = (u >> 4) & 7, b = u >> 7; const size_t row0 = (size_t)NCTX + b * LSEQ + qb * 256;
            q = Q + row0 * DM + h * 256 + p * 128; k = Ka + (size_t)b * KVL * DM + h * 256 + p * 128; v = Va + (size_t)b * KVL * DM + h * 256 + vh * 128; o = O + row0 * 4096 + (h * 2 + p) * 256 + vh * 128; seq = KVL; }
        else { const int u = it - 256, vh = u & 1, p = (u >> 1) & 1, h = (u >> 2) & 7, b = u >> 5; const size_t row0 = (size_t)b * CSEQ;
            q = Q + row0 * DM + h * 256 + p * 128; k = Kc + row0 * DM + h * 256 + p * 128; v = Vc + row0 * DM + h * 256 + vh * 128; o = O + row0 * 4096 + (h * 2 + p) * 256 + vh * 128; seq = CSEQ; }
        att::attn_body<DM, DM, 4096, true>(q, k, v, o, seq, F.lds + RING_OFF, F.wave);
    }
}
__device__ __forceinline__ void p_attn_b(Frame& F) {
    const unsigned short* Q = wsp<unsigned short>(F, WS_Q); const unsigned short* Kc = wsp<unsigned short>(F, WS_KCTX); const unsigned short* Vc = wsp<unsigned short>(F, WS_VCTX);
    const unsigned short* Ka = wsp<unsigned short>(F, WS_KALLB); const unsigned short* Va = wsp<unsigned short>(F, WS_VALLB);
    unsigned short* O = wsp<unsigned short>(F, WS_OB);
    for (int it = F.vcu; it < 384; it += F.G) {
        const unsigned short *q, *k, *v; unsigned short* o; int seq;
        if (it >= 128 && it < 256) { const int u = it - 128, qb = u & 3, hq = (u >> 2) & 15, b = u >> 6; const size_t row0 = (size_t)NCTX + b * LSEQ + qb * 256;
            q = Q + row0 * DM + hq * 128; k = Ka + (size_t)b * KVL * 512 + (hq >> 2) * 128; v = Va + (size_t)b * KVL * 512 + (hq >> 2) * 128; o = O + row0 * DM + hq * 128; seq = KVL; }
        else { const int u = it < 128 ? it : it - 128, hq = u & 15, b = u >> 4; const size_t row0 = (size_t)b * CSEQ;
            q = Q + row0 * DM + hq * 128; k = Kc + row0 * 512 + (hq >> 2) * 128; v = Vc + row0 * 512 + (hq >> 2) * 128; o = O + row0 * DM + hq * 128; seq = CSEQ; }
        att::attn_body<DM, 512, DM, false>(q, k, v, o, seq, F.lds + RING_OFF, F.wave);
    }
}

#ifndef MK_PER_PHASE
#define MK_PER_PHASE 0
#endif
constexpr int N_PHASES = 36;
#define PH_IN(k) (lo <= (k) && (k) < hi)
#define PH_END(k) do { if (PH_IN(k) && PH_IN((k) + 1)) xcd_barrier(bar, F.wave); } while (0)

template <class Epi> __device__ __forceinline__ void run_gemm(Frame& F, const unsigned short* A, const unsigned short* Bt, int M, int N, int K, const Epi& E, int c) {
    if (c < 0) return;
    pg8::Gemm g{A, Bt, M, N, K}; pg8::StaticOrder S; S.init(M, N, F.G, c);
    pg8::gemm_phase<Epi, pg8::StaticOrder, true, true>(F.lds + RING_OFF, g, S, E, F.wave);
}
template <int L, int P> __device__ __forceinline__ void mlp_half(Frame& F, const XcdBarrier& bar, int lo, int hi) {
    const float* MOD = wsp<float>(F, WS_MOD) + (size_t)L * MODL;
    if (PH_IN(P)) p_layernorm(F, in_ptr(10) + (size_t)(L * 2 + 0) * DM, in_ptr(11) + (size_t)(L * 2 + 0) * DM, wsp<float>(F, WS_X), MOD, 3, 4);
    PH_END(P);
    if (PH_IN(P + 1)) { pg8::EpiRelu2 E{wsp<unsigned short>(F, WS_HID), DFF};
        run_gemm(F, wsp<unsigned short>(F, WS_U), wsp<unsigned short>(F, WS_WUP) + (size_t)L * DFF * DM, MTOK, DFF, DM, E, (int)blockIdx.x); }
    PH_END(P + 1);
    if (PH_IN(P + 2)) { pg8::EpiResid E{wsp<float>(F, WS_X), wsp<float>(F, WS_H), MOD + 5 * DM, DM, MODW, ALPHA_F};
        run_gemm(F, wsp<unsigned short>(F, WS_HID), wsp<unsigned short>(F, WS_WDOWN) + (size_t)L * DM * DFF, MTOK, DM, DFF, E, (int)blockIdx.x); }
    PH_END(P + 2);
    if (PH_IN(P + 3)) {
        if constexpr (L < 3) p_layernorm(F, in_ptr(10) + (size_t)(L * 2 + 1) * DM, in_ptr(11) + (size_t)(L * 2 + 1) * DM, wsp<float>(F, WS_X), MOD + MODL, 0, 1);
        else p_layernorm(F, in_ptr(10) + (size_t)(L * 2 + 1) * DM, in_ptr(11) + (size_t)(L * 2 + 1) * DM, F.out, nullptr, 0, 1);
    }
    if constexpr (L < 3) PH_END(P + 3);
}
template <int L, int J, int P> __device__ __forceinline__ void mixer_a(Frame& F, const XcdBarrier& bar, int lo, int hi) {
    const float* MOD = wsp<float>(F, WS_MOD) + (size_t)L * MODL;
    constexpr float LAM_INIT = (L == 0) ? 0.2f : 0.5560582044f;
    unsigned short* Kall = wsp<unsigned short>(F, WS_KALLA) + (size_t)J * 2 * KVL * DM; unsigned short* Vall = wsp<unsigned short>(F, WS_VALLA) + (size_t)J * 2 * KVL * DM;
    if (PH_IN(P)) { pg8::EpiRoute<RouterQkvA> E{{wsp<unsigned short>(F, WS_Q), wsp<unsigned short>(F, WS_KCTX), wsp<unsigned short>(F, WS_VCTX), Vall, wsp<float>(F, WS_QKTMP),
                                                  F.out + OUT_AK + (size_t)J * 256 * DM, F.out + OUT_AV + (size_t)J * 256 * DM}};
        run_gemm(F, wsp<unsigned short>(F, WS_U), wsp<unsigned short>(F, WS_WQKVA) + (size_t)J * 6144 * DM, MTOK, 6144, DM, E, (int)blockIdx.x); }
    PH_END(P);
    if (PH_IN(P + 1)) p_rope_a(F, Kall);
    PH_END(P + 1);
    if (PH_IN(P + 2)) p_attn_a(F, J);
    PH_END(P + 2);
    if (PH_IN(P + 3)) p_combine_a(F, J, LAM_INIT);
    PH_END(P + 3);
    if (PH_IN(P + 4)) { pg8::EpiResid E{wsp<float>(F, WS_X), wsp<float>(F, WS_H), MOD + 2 * DM, DM, MODW, ALPHA_F};
        run_gemm(F, wsp<unsigned short>(F, WS_OB), wsp<unsigned short>(F, WS_WOA) + (size_t)J * DM * DM, MTOK, DM, DM, E, (int)blockIdx.x); }
    PH_END(P + 4);
}
template <int L, int P> __device__ __forceinline__ void mixer_b(Frame& F, const XcdBarrier& bar, int lo, int hi) {
    const float* MOD = wsp<float>(F, WS_MOD) + (size_t)L * MODL;
    if (PH_IN(P)) { pg8::EpiRoute<RouterQkvB> E{{wsp<unsigned short>(F, WS_VCTX), wsp<unsigned short>(F, WS_VALLB), wsp<float>(F, WS_QKTMP), F.out + OUT_BV}};
        run_gemm(F, wsp<unsigned short>(F, WS_U), wsp<unsigned short>(F, WS_WQKVB), MTOK, 3072, DM, E, (int)blockIdx.x); }
    PH_END(P);
    if (PH_IN(P + 1)) p_norm_rope_b(F);
    PH_END(P + 1);
    if (PH_IN(P + 2)) p_attn_b(F);
    PH_END(P + 2);
    if (PH_IN(P + 3)) { pg8::EpiResid E{wsp<float>(F, WS_X), wsp<float>(F, WS_H), MOD + 2 * DM, DM, MODW, ALPHA_F};
        run_gemm(F, wsp<unsigned short>(F, WS_OB), wsp<unsigned short>(F, WS_WOB), MTOK, DM, DM, E, (int)blockIdx.x); }
    PH_END(P + 3);
}
template <int L, int P> __device__ __forceinline__ void mixer_c(Frame& F, const XcdBarrier& bar, int lo, int hi) {
    const float* MOD = wsp<float>(F, WS_MOD) + (size_t)L * MODL;
    if (PH_IN(P)) { pg8::EpiRoute<RouterDft1> E{{wsp<unsigned short>(F, WS_ZCTX), wsp<unsigned short>(F, WS_ZLAT)}};
        run_gemm(F, wsp<unsigned short>(F, WS_DFTW), wsp<unsigned short>(F, WS_U), 4096, MTOK, DM, E, (int)blockIdx.x); }
    PH_END(P);
    if (PH_IN(P + 1)) {
        { pg8::EpiRoute<RouterDft2Lat> E{{wsp<unsigned short>(F, WS_OB)}};
          run_gemm(F, wsp<unsigned short>(F, WS_DSLAT), wsp<unsigned short>(F, WS_ZLAT), 1024, 4096, 2048, E, (int)blockIdx.x); }
        { pg8::EpiRoute<RouterDft2Ctx> E{{wsp<unsigned short>(F, WS_OB)}};
          run_gemm(F, wsp<unsigned short>(F, WS_DSCTX), wsp<unsigned short>(F, WS_ZCTX), 256, 32768, 512, E, (int)blockIdx.x - 64); }
    }
    PH_END(P + 1);
    if (PH_IN(P + 2)) { pg8::EpiResid E{wsp<float>(F, WS_X), wsp<float>(F, WS_H), MOD + 2 * DM, DM, MODW, ALPHA_F};
        run_gemm(F, wsp<unsigned short>(F, WS_OB), wsp<unsigned short>(F, WS_WF), MTOK, DM, DM, E, (int)blockIdx.x); }
    PH_END(P + 2);
}

__global__ void __launch_bounds__(NWAVES * 64, 2) mk_fwd(Args args) {
    extern __shared__ __attribute__((aligned(16))) unsigned char lds[];
    Frame F;
    F.lds = (LAS unsigned char*)lds;
    F.MISC = (volatile LAS unsigned*)(F.lds + MISC_OFF);
    F.wave = __builtin_amdgcn_readfirstlane((int)threadIdx.x >> 6);
    F.G = gridDim.x; { const int bx = blockIdx.x; F.vcu = (F.G % 8 == 0) ? (bx % 8) * (F.G / 8) + bx / 8 : bx; }
    F.out = args.out; F.ws = args.ws; F.ctl = (gu32*)(args.ws + WS_CTL);
    for (int u = (int)threadIdx.x; u < (LDS_BYTES - LDSCTL_OFF) / 4; u += NWAVES * 64) ((LAS unsigned*)(F.lds + LDSCTL_OFF))[u] = 0u;
    __syncthreads();
    XcdBarrier bar; bar.bar = (unsigned*)(F.ctl + CW_BAR); bar.x = 0; bar.st = nullptr;
    if (!MK_PER_PHASE) bar = xcd_barrier_post((unsigned*)(F.ctl + CW_BAR), F.MISC + 8);
    const int lo = args.ph_lo, hi = args.ph_hi;

    if (PH_IN(0)) p0_prologue(F);
    PH_END(0);
    if (PH_IN(1)) p_mod_reduce(F);
    PH_END(1);
    if (PH_IN(2)) p_modulate0(F);
    PH_END(2);
    mixer_a<0, 0, 3>(F, bar, lo, hi);  mlp_half<0, 8>(F, bar, lo, hi);
    mixer_b<1, 12>(F, bar, lo, hi);    mlp_half<1, 16>(F, bar, lo, hi);
    mixer_c<2, 20>(F, bar, lo, hi);    mlp_half<2, 23>(F, bar, lo, hi);
    mixer_a<3, 1, 27>(F, bar, lo, hi); mlp_half<3, 32>(F, bar, lo, hi);
}

extern "C" void kernel_launch(void* const* d_in, const int* in_sizes, int n_in, void* d_out, int out_size, void* d_ws, size_t ws_size, hipStream_t stream) {
    static int grid = 0;
    if (grid == 0) {
        if (n_in != 23 || out_size != (int)OUT_TOTAL || ws_size < WS_END) { fprintf(stderr, "kernel_launch: unexpected shapes: n_in %d out %d ws %zu (need %zu)\n", n_in, out_size, ws_size, (size_t)WS_END); grid = -1; return; }
        int dev = 0, cus = 0, per_cu = 0;
        if (hipGetDevice(&dev) != hipSuccess || hipDeviceGetAttribute(&cus, hipDeviceAttributeMultiprocessorCount, dev) != hipSuccess) { fprintf(stderr, "kernel_launch: device query failed\n"); grid = -1; return; }
        if (hipFuncSetAttribute((const void*)mk_fwd, hipFuncAttributeMaxDynamicSharedMemorySize, LDS_BYTES) != hipSuccess) { fprintf(stderr, "kernel_launch: hipFuncSetAttribute failed\n"); grid = -1; return; }
        if (hipOccupancyMaxActiveBlocksPerMultiprocessor(&per_cu, (const void*)mk_fwd, NWAVES * 64, LDS_BYTES) != hipSuccess || per_cu < 1)
            fprintf(stderr, "kernel_launch: note: occupancy query reports %d workgroups per CU\n", per_cu);
        (void)hipGetLastError();
        grid = cus;
        if (grid != 256) fprintf(stderr, "kernel_launch: note: %d CUs (tuned for 256)\n", grid);
    }
    if (grid < 0) return;
    if (hipMemsetAsync((char*)d_ws + WS_CTL, 0, CTL_ZERO_BYTES, stream) != hipSuccess) { fprintf(stderr, "kernel_launch: memset failed\n"); return; }
    Args a{};
    for (int i = 0; i < 23; ++i) a.in[i] = (const float*)d_in[i];
    a.out = (float*)d_out; a.ws = (unsigned char*)d_ws; a.pad = 0;
#if MK_PER_PHASE
    for (int p = 0; p < N_PHASES; ++p) { a.ph_lo = p; a.ph_hi = p + 1; a.li = p;
        hipLaunchKernelGGL(mk_fwd, dim3(grid), dim3(NWAVES * 64), LDS_BYTES, stream, a); }
#else
    a.ph_lo = 0; a.ph_hi = N_PHASES; a.li = 0;
    hipLaunchKernelGGL(mk_fwd, dim3(grid), dim3(NWAVES * 64), LDS_BYTES, stream, a);
#endif
    const hipError_t le = hipPeekAtLastError();
    if (le != hipSuccess) fprintf(stderr, "kernel_launch: launch failed: %s\n", hipGetErrorName(le));
}
```

```cpp
#include <hip/hip_runtime.h>
#include <cstdio>
#include <cstdint>
namespace pg8 {
#define PG8_LAS __attribute__((address_space(3)))
typedef unsigned short bf16_t;
typedef short bf16x8 __attribute__((ext_vector_type(8)));
typedef float f32x4 __attribute__((ext_vector_type(4)));
typedef unsigned u32x4 __attribute__((ext_vector_type(4)));
constexpr int BM = 256, BK = 64, HALF = 128, HTB = HALF * BK * 2  , STAGE_BYTES = 8 * HTB, NXCD = 8, WGM = 8;

__host__ __device__ __forceinline__ int lds_byte(int r, int c) { const int st = (r >> 4) * 2 + (c >> 5), rr = r & 15, cc = c & 31, ob = rr * 64 + cc * 2; return st * 1024 + (ob ^ (((ob >> 9) & 1) << 5)); }
__host__ __device__ __forceinline__ void stage_rc(int b, int& R, int& C) { const int st = b / 1024, sb = b % 1024, swz = sb ^ (((sb >> 9) & 1) << 5); R = (st >> 1) * 16 + swz / 64; C = (st & 1) * 32 + (swz % 64) / 2; }
__host__ __device__ __forceinline__ int perm32(int rho) { const int n = rho >> 4, i = rho & 15; return 8 * (i >> 2) + 4 * n + (i & 3); }

struct Unit { int pm, pn; };
struct Gemm { const bf16_t* A; const bf16_t* Bt; int M, N, K; };

struct StaticOrder {
    int nM, nN, nwg, G, c;
    __host__ __device__ void init(int M, int N, int G_, int c_) { nM = M / BM; nN = N / BM; nwg = nM * nN; G = G_; c = c_; }
    __host__ __device__ bool next(int i, Unit& u) const {
        const long L = (long)i * G + c; if (L >= nwg) return false;
        int wgid = (int)L; { const int q = nwg / NXCD, r = nwg % NXCD, xcd = wgid % NXCD, off = wgid / NXCD; wgid = (xcd < r ? xcd * (q + 1) : r * (q + 1) + (xcd - r) * q) + off; }
        const int nig = WGM * nN, gid = wgid / nig, fm = gid * WGM, gsz = (nM - fm) < WGM ? (nM - fm) : WGM;
        u.pm = fm + ((wgid % nig) % gsz); u.pn = (wgid % nig) / gsz; return true;
    }
    __device__ __forceinline__ void a_ready(const Unit&) const {}
    __device__ __forceinline__ void done(const Unit&) const {}
};

__device__ __forceinline__ unsigned cvt_pk_bf16(float lo, float hi) { unsigned r; asm volatile("v_cvt_pk_bf16_f32 %0, %1, %2" : "=v"(r) : "v"(lo), "v"(hi)); return r; }

struct Route { bf16_t* ob; float* of; int ldb, ldf; };
template <class Router> struct EpiRoute {
    static constexpr bool PERM = true, AFTER_DRAIN = false;
    Router R;
    __device__ __forceinline__ void operator()(const f32x4 (&acc)[2][2][4][2], const Unit& u, int wr, int wc, int fr, int fq) const {
        const Route rt = R(u);
        const int r0 = wr * 64 + fr, c0 = wc * 32 + 8 * fq;
        if (rt.ob) {
#pragma unroll
            for (int ai = 0; ai < 2; ++ai)
#pragma unroll
                for (int m = 0; m < 4; ++m) { bf16_t* rowp = rt.ob + (size_t)(r0 + ai * HALF + m * 16) * rt.ldb + c0;
#pragma unroll
                    for (int bj = 0; bj < 2; ++bj) { const f32x4 v0 = acc[ai][bj][m][0], v1 = acc[ai][bj][m][1];
                        u32x4 w; w.x = cvt_pk_bf16(v0[0], v0[1]); w.y = cvt_pk_bf16(v0[2], v0[3]); w.z = cvt_pk_bf16(v1[0], v1[1]); w.w = cvt_pk_bf16(v1[2], v1[3]);
                        *(u32x4*)(rowp + bj * HALF) = w; } }
        }
        if (rt.of) {
#pragma unroll
            for (int ai = 0; ai < 2; ++ai)
#pragma unroll
                for (int m = 0; m < 4; ++m) { float* rowp = rt.of + (size_t)(r0 + ai * HALF + m * 16) * rt.ldf + c0;
#pragma unroll
                    for (int bj = 0; bj < 2; ++bj) { *(f32x4*)(rowp + bj * HALF) = acc[ai][bj][m][0]; *(f32x4*)(rowp + bj * HALF + 4) = acc[ai][bj][m][1]; } }
        }
    }
};
struct EpiRelu2 {
    static constexpr bool PERM = true, AFTER_DRAIN = false;
    bf16_t* O; int ldc;
    __device__ __forceinline__ void operator()(const f32x4 (&acc)[2][2][4][2], const Unit& u, int wr, int wc, int fr, int fq) const {
        const int row0 = u.pm * BM + wr * 64 + fr, col0 = u.pn * BM + wc * 32 + 8 * fq;
#pragma unroll
        for (int ai = 0; ai < 2; ++ai)
#pragma unroll
            for (int m = 0; m < 4; ++m) { bf16_t* rowp = O + (size_t)(row0 + ai * HALF + m * 16) * ldc + col0;
#pragma unroll
                for (int bj = 0; bj < 2; ++bj) { f32x4 v0 = acc[ai][bj][m][0], v1 = acc[ai][bj][m][1];
#pragma unroll
                    for (int j = 0; j < 4; ++j) { const float a = fmaxf(v0[j], 0.f), b = fmaxf(v1[j], 0.f); v0[j] = a * a; v1[j] = b * b; }
                    u32x4 w; w.x = cvt_pk_bf16(v0[0], v0[1]); w.y = cvt_pk_bf16(v0[2], v0[3]); w.z = cvt_pk_bf16(v1[0], v1[1]); w.w = cvt_pk_bf16(v1[2], v1[3]);
                    *(u32x4*)(rowp + bj * HALF) = w; } }
    }
};
struct EpiResid {
    static constexpr bool PERM = false, AFTER_DRAIN = false;
    const float* X; float* H; const float* gate; int ldc, gstride; float alpha;
    __device__ __forceinline__ void operator()(const f32x4 (&acc)[2][2][4][2], const Unit& u, int wr, int wc, int fr, int fq) const {
        const int row0 = u.pm * BM + wr * 64 + fr, col0 = u.pn * BM + wc * 32 + 4 * fq;
        const int cond = u.pm < 16 ? 0 : 1 + ((u.pm - 16) >> 2);
        const float* g = gate + (size_t)cond * gstride + col0;
        f32x4 gv[2][2];
#pragma unroll
        for (int bj = 0; bj < 2; ++bj)
#pragma unroll
            for (int n = 0; n < 2; ++n) gv[bj][n] = *(const f32x4*)(g + bj * HALF + n * 16);
#pragma unroll
        for (int ai = 0; ai < 2; ++ai)
#pragma unroll
            for (int m = 0; m < 4; ++m) { const size_t off = (size_t)(row0 + ai * HALF + m * 16) * ldc + col0;
#pragma unroll
                for (int bj = 0; bj < 2; ++bj)
#pragma unroll
                    for (int n = 0; n < 2; ++n) { const f32x4 xv = *(const f32x4*)(X + off + bj * HALF + n * 16);
                        *(f32x4*)(H + off + bj * HALF + n * 16) = xv * alpha + gv[bj][n] * acc[ai][bj][m][n]; }
                asm volatile("" ::: "memory"); }
    }
};

template <class Epi, class Sched, bool ALIGN_EPI = false, bool SP2 = false>
__device__ __forceinline__ void gemm_phase(PG8_LAS unsigned char* lds, const Gemm g, const Sched& S, const Epi& E, const int wid  ) {
    const int lane = (int)__builtin_amdgcn_mbcnt_hi(~0u, __builtin_amdgcn_mbcnt_lo(~0u, 0u)), tid = wid * 64 + lane, wr = wid >> 2, wc = wid & 3, fr = lane & 15, fq = lane >> 4;
    const int K = g.K, nt = K / BK;
    unsigned voffA[2], voffB[2];
#pragma unroll
    for (int i = 0; i < 2; ++i) { int R, C; stage_rc(tid * 16 + i * 8192, R, C); const int Rb = Epi::PERM ? ((R & ~31) + perm32(R & 31)) : R;
        voffA[i] = (unsigned)(R * K + C) * 2u; voffB[i] = (unsigned)(Rb * K + C) * 2u; }
    const size_t kstep = (size_t)(BK * 2);
    const size_t hstep = (size_t)HALF * K * 2;
    const size_t tstep = 2 * hstep;
    const unsigned ldsw = (unsigned)wid * 1024u;
    const int aoff = lds_byte(wr * 64 + fr, fq * 8), boff = lds_byte(wc * 32 + fr, fq * 8);
#define PG8_SA(b, h) (((b) * 2 + (h)) * HTB)
#define PG8_SB(b, h) ((4 + (b) * 2 + (h)) * HTB)
#define PG8_STAGE(bufoff, gbase, voff) do { _Pragma("unroll") for (int _i = 0; _i < 2; ++_i) \
        __builtin_amdgcn_global_load_lds((const unsigned*)((const char*)(gbase) + (voff)[_i]), (PG8_LAS unsigned*)(lds + (bufoff) + ldsw + _i * 8192), 16, 0, 0); } while (0)
#define PG8_LDA(dst, b, h) do { _Pragma("unroll") for (int m = 0; m < 4; ++m) _Pragma("unroll") for (int k = 0; k < 2; ++k) dst[m][k] = *(const PG8_LAS bf16x8*)(lds + PG8_SA(b, h) + aoff + m * 2048 + k * 1024); } while (0)
#define PG8_LDB(dst, b, h) do { _Pragma("unroll") for (int n = 0; n < 2; ++n) _Pragma("unroll") for (int k = 0; k < 2; ++k) dst[n][k] = *(const PG8_LAS bf16x8*)(lds + PG8_SB(b, h) + boff + n * 2048 + k * 1024); } while (0)
#define PG8_MMA(ai, bj, At, Bt) do { __builtin_amdgcn_s_setprio(1); _Pragma("unroll") for (int m = 0; m < 4; ++m) _Pragma("unroll") for (int n = 0; n < 2; ++n) _Pragma("unroll") for (int k = 0; k < 2; ++k) \
        acc[ai][bj][m][n] = __builtin_amdgcn_mfma_f32_16x16x32_bf16(Bt[n][k], At[m][k], acc[ai][bj][m][n], 0, 0, 0); __builtin_amdgcn_s_setprio(0); } while (0)
#define PG8_WAIT_V(n) asm volatile("s_waitcnt vmcnt(" #n ")" ::: "memory")
#define PG8_WAIT_L(n) asm volatile("s_waitcnt lgkmcnt(" #n ")" ::: "memory")
#define PG8_BAR __builtin_amdgcn_s_barrier()
#define PG8_SCHED __builtin_amdgcn_sched_barrier(0)
    Unit cur, nxt; int ui = 0;
    if (!S.next(0, cur)) return;
    f32x4 acc[2][2][4][2];
#pragma unroll
    for (int a = 0; a < 2; ++a)
#pragma unroll
        for (int b = 0; b < 2; ++b)
#pragma unroll
            for (int m = 0; m < 4; ++m)
#pragma unroll
                for (int n = 0; n < 2; ++n) acc[a][b][m][n] = (f32x4){0.f, 0.f, 0.f, 0.f};
    bf16x8 At[4][2], B0[2][2], B1[2][2];
    const char* cA = (const char*)g.A + (size_t)cur.pm * tstep; const char* cB = (const char*)g.Bt + (size_t)cur.pn * tstep;
    S.a_ready(cur);
    if constexpr (SP2) {
        PG8_STAGE(PG8_SB(0, 0), cB, voffB); PG8_STAGE(PG8_SB(0, 1), cB + hstep, voffB); PG8_STAGE(PG8_SA(0, 0), cA, voffA); PG8_STAGE(PG8_SA(0, 1), cA + hstep, voffA);
        if (wr == 1) PG8_BAR;
        PG8_WAIT_V(2); PG8_BAR;
        PG8_STAGE(PG8_SB(1, 0), cB + kstep, voffB); PG8_STAGE(PG8_SA(1, 0), cA + kstep, voffA); PG8_STAGE(PG8_SB(1, 1), cB + hstep + kstep, voffB);
        PG8_WAIT_V(6); PG8_BAR;
    } else {
        PG8_STAGE(PG8_SB(0, 0), cB, voffB); PG8_STAGE(PG8_SA(0, 0), cA, voffA); PG8_STAGE(PG8_SB(0, 1), cB + hstep, voffB); PG8_STAGE(PG8_SA(0, 1), cA + hstep, voffA);
        if (wr == 1) PG8_BAR;
        PG8_WAIT_V(4); PG8_BAR;
        PG8_STAGE(PG8_SB(1, 0), cB + kstep, voffB); PG8_STAGE(PG8_SA(1, 0), cA + kstep, voffA); PG8_STAGE(PG8_SB(1, 1), cB + hstep + kstep, voffB);
        PG8_WAIT_V(6); PG8_BAR;
    }
    for (;;) {
        const bool has_next = S.next(ui + 1, nxt);
        const char* nA = has_next ? (const char*)g.A + (size_t)nxt.pm * tstep : cA; const char* nB = has_next ? (const char*)g.Bt + (size_t)nxt.pn * tstep : cB;
        for (int t = 0; t < nt; t += 2) {
            const bool last = (t == nt - 2);
            const char* a1 = cA + (size_t)(t + 1) * kstep;
            const char* a2 = last ? nA : cA + (size_t)(t + 2) * kstep; const char* b2 = last ? nB : cB + (size_t)(t + 2) * kstep;
            const char* a3 = a2 + kstep; const char* b3 = b2 + kstep;
            if (last && has_next) S.a_ready(nxt);
            if constexpr (SP2) {
            PG8_LDB(B0, 0, 0); PG8_LDB(B1, 0, 1); PG8_SCHED; PG8_LDA(At, 0, 0); PG8_STAGE(PG8_SA(1, 1), a1 + hstep, voffA);
            PG8_WAIT_V(8); PG8_WAIT_L(0); PG8_BAR; PG8_MMA(0, 0, At, B0); PG8_MMA(0, 1, At, B1); PG8_BAR; PG8_SCHED;
            PG8_LDA(At, 0, 1); PG8_STAGE(PG8_SB(0, 0), b2, voffB); PG8_STAGE(PG8_SB(0, 1), b2 + hstep, voffB); PG8_STAGE(PG8_SA(0, 0), a2, voffA);
            PG8_WAIT_V(8); PG8_WAIT_L(0); PG8_BAR; PG8_MMA(1, 0, At, B0); PG8_MMA(1, 1, At, B1); PG8_BAR; PG8_SCHED;
            PG8_LDB(B0, 1, 0); PG8_LDB(B1, 1, 1); PG8_SCHED; PG8_LDA(At, 1, 0); PG8_STAGE(PG8_SA(0, 1), a2 + hstep, voffA);
            PG8_WAIT_V(8); PG8_WAIT_L(0); PG8_BAR; PG8_MMA(0, 0, At, B0); PG8_MMA(0, 1, At, B1); PG8_BAR; PG8_SCHED;
            PG8_LDA(At, 1, 1); PG8_STAGE(PG8_SB(1, 0), b3, voffB); PG8_STAGE(PG8_SB(1, 1), b3 + hstep, voffB); PG8_STAGE(PG8_SA(1, 0), a3, voffA);
            PG8_WAIT_V(8); PG8_WAIT_L(0); PG8_BAR; PG8_MMA(1, 0, At, B0); PG8_MMA(1, 1, At, B1); PG8_BAR; PG8_SCHED;
            } else {
            PG8_LDB(B0, 0, 0); PG8_SCHED; PG8_LDA(At, 0, 0); PG8_STAGE(PG8_SA(1, 1), a1 + hstep, voffA);
            PG8_WAIT_L(8); PG8_BAR; PG8_WAIT_L(0); PG8_MMA(0, 0, At, B0); PG8_BAR; PG8_SCHED;
            PG8_LDB(B1, 0, 1); PG8_STAGE(PG8_SB(0, 0), b2, voffB);
            PG8_BAR; PG8_WAIT_L(0); PG8_MMA(0, 1, At, B1); PG8_BAR;
            PG8_LDA(At, 0, 1); PG8_STAGE(PG8_SA(0, 0), a2, voffA);
            PG8_BAR; PG8_WAIT_L(0); PG8_MMA(1, 0, At, B0); PG8_BAR; PG8_SCHED;
            PG8_STAGE(PG8_SB(0, 1), b2 + hstep, voffB);
            PG8_WAIT_V(6); PG8_BAR; PG8_MMA(1, 1, At, B1); PG8_BAR;
            PG8_LDB(B0, 1, 0); PG8_SCHED; PG8_LDA(At, 1, 0); PG8_STAGE(PG8_SA(0, 1), a2 + hstep, voffA);
            PG8_WAIT_L(8); PG8_BAR; PG8_WAIT_L(0); PG8_MMA(0, 0, At, B0); PG8_BAR; PG8_SCHED;
            PG8_LDB(B1, 1, 1); PG8_STAGE(PG8_SB(1, 0), b3, voffB);
            PG8_BAR; PG8_WAIT_L(0); PG8_MMA(0, 1, At, B1); PG8_BAR;
            PG8_LDA(At, 1, 1); PG8_STAGE(PG8_SA(1, 0), a3, voffA);
            PG8_BAR; PG8_WAIT_L(0); PG8_MMA(1, 0, At, B0); PG8_BAR; PG8_SCHED;
            PG8_STAGE(PG8_SB(1, 1), b3 + hstep, voffB);
            PG8_WAIT_V(6); PG8_BAR; PG8_MMA(1, 1, At, B1); PG8_BAR;
            }
        }
        if constexpr (ALIGN_EPI) { if (wr == 0) PG8_BAR; }
        if constexpr (!Epi::AFTER_DRAIN) { E(acc, cur, wr, wc, fr, fq); S.done(cur); }
        if (!has_next) break;
#pragma unroll
        for (int a = 0; a < 2; ++a)
#pragma unroll
            for (int b = 0; b < 2; ++b)
#pragma unroll
                for (int m = 0; m < 4; ++m)
#pragma unroll
                    for (int n = 0; n < 2; ++n) acc[a][b][m][n] = (f32x4){0.f, 0.f, 0.f, 0.f};
        cur = nxt; cA = nA; cB = nB; ++ui;
        if constexpr (ALIGN_EPI) { if (wr == 1) PG8_BAR; }
    }
    PG8_WAIT_V(0);
    if constexpr (!ALIGN_EPI) { if (wr == 0) PG8_BAR; }
    PG8_BAR;
    if constexpr (Epi::AFTER_DRAIN) { E.fused(acc, cur, wr, wc, fr, fq, lds, wid, lane); S.done(cur); }
#undef PG8_SA
#undef PG8_SB
#undef PG8_STAGE
#undef PG8_LDA
#undef PG8_LDB
#undef PG8_MMA
#undef PG8_WAIT_V
#undef PG8_WAIT_L
#undef PG8_BAR
#undef PG8_SCHED
}
}
#define GAS __attribute__((address_space(1)))
#define LAS __attribute__((address_space(3)))
typedef unsigned short bf16;
typedef unsigned v4u __attribute__((ext_vector_type(4)));
typedef float f32x4 __attribute__((ext_vector_type(4)));
typedef short bf16x8 __attribute__((ext_vector_type(8)));
typedef GAS unsigned gu32;
typedef GAS unsigned long long gu64;
#define RLX_AGENT __ATOMIC_RELAXED, __HIP_MEMORY_SCOPE_AGENT
#define LDS_WAIT() asm volatile("s_waitcnt lgkmcnt(0)" ::: "memory")
#define VM_WAIT() asm volatile("s_waitcnt vmcnt(0)" ::: "memory")
__device__ __forceinline__ unsigned long long rt() { return __builtin_amdgcn_s_memrealtime(); }
__device__ __forceinline__ unsigned f2bf(float f) { unsigned u = __builtin_bit_cast(unsigned, f); return (u + 0x7fffu + ((u >> 16) & 1u)) >> 16; }
__device__ __forceinline__ unsigned pk2(float lo, float hi) { return f2bf(lo) | (f2bf(hi) << 16); }

#define XB_TMO      128
#define XB_XCNT(j)  (256  + 64 * (j))
#define XB_XSUB(j)  (1280 + 64 * (j))
#define XB_XGEN(j)  (2304 + 64 * (j))
#define XB_TOP      3328
#define XB_TOPGEN   3392
#define XCD_BAR_WORDS 3456
#define XB_SPIN_CAP (1u << 18)

__device__ __forceinline__ unsigned xb_ld(unsigned* p)              { return __hip_atomic_load(p, __ATOMIC_RELAXED, __HIP_MEMORY_SCOPE_AGENT); }
__device__ __forceinline__ unsigned xb_add(unsigned* p, unsigned v) { return __hip_atomic_fetch_add(p, v, __ATOMIC_RELAXED, __HIP_MEMORY_SCOPE_AGENT); }
__device__ __forceinline__ unsigned xb_xcc_id() { return (unsigned)__builtin_amdgcn_s_getreg((3 << 11) | 20) & 0xFu; }
#define XB_SPIN(cond, bar) do { unsigned _sp = 0; while (cond) { __builtin_amdgcn_s_sleep(1); \
    if ((++_sp & 255u) == 0u) { if (xb_ld(&(bar)[XB_TMO])) break; if (_sp > XB_SPIN_CAP) { atomicAdd(&(bar)[XB_TMO], 1u); break; } } } } while (0)

struct XcdBarrier {
    unsigned* bar; unsigned x;
    volatile LAS unsigned* st;
};

__device__ __forceinline__ XcdBarrier xcd_barrier_post(unsigned* bar, volatile LAS unsigned* st) {
    XcdBarrier b; b.bar = bar; b.x = xb_xcc_id(); b.st = st;
    if (threadIdx.x == 0) (void)xb_add(&bar[XB_XCNT(b.x)], 1u);
    return b;
}
__device__ __forceinline__ void xcd_barrier_complete(unsigned* bar, unsigned x, unsigned& nloc, unsigned& nx) {
    const unsigned G = gridDim.x * gridDim.y * gridDim.z;
    unsigned sum, cnt, mine, sp = 0u;
    for (;;) {
        sum = 0u; cnt = 0u; mine = 0u;
#pragma unroll
        for (unsigned j = 0; j < 16; ++j) { const unsigned c = xb_ld(&bar[XB_XCNT(j)]); sum += c; cnt += (c > 0u) ? 1u : 0u; mine = (j == x) ? c : mine; }
        if (sum == G) break;
        __builtin_amdgcn_s_sleep(1);
        if ((++sp & 255u) == 0u) { if (xb_ld(&bar[XB_TMO])) break; if (sp > XB_SPIN_CAP) { atomicAdd(&bar[XB_TMO], 1u); break; } }
    }
    nloc = mine > 0u ? mine : 1u; nx = cnt > 0u ? cnt : 1u;
}

__device__ __forceinline__ void xcd_barrier(const XcdBarrier& b, const int wid  ) {
    asm volatile("s_waitcnt vmcnt(0)" ::: "memory");
    __syncthreads();
    if (wid == 0 && __builtin_amdgcn_mbcnt_hi(~0u, __builtin_amdgcn_mbcnt_lo(~0u, 0u)) == 0u) {
        unsigned* bar = b.bar;
        __builtin_amdgcn_s_waitcnt(0);
        unsigned nloc = b.st[0], nx = b.st[1];
        if (nloc == 0u) { xcd_barrier_complete(bar, b.x, nloc, nx); b.st[0] = nloc; b.st[1] = nx; }
        const unsigned old = xb_add(&bar[XB_XSUB(b.x)], 1u);
        const unsigned gen = old / nloc;
        if (old + 1u == (gen + 1u) * nloc) {
            __builtin_amdgcn_fence(__ATOMIC_RELEASE, "agent");
            asm volatile("s_waitcnt vmcnt(0)" ::: "memory");
            const unsigned og = xb_add(&bar[XB_TOP], 1u);
            const unsigned tg = og / nx;
            if (og + 1u == (tg + 1u) * nx) xb_add(&bar[XB_TOPGEN], 1u);
            else XB_SPIN(xb_ld(&bar[XB_TOPGEN]) == tg, bar);
            __builtin_amdgcn_fence(__ATOMIC_ACQUIRE, "agent");
            xb_add(&bar[XB_XGEN(b.x)], 1u);
            asm volatile("s_waitcnt vmcnt(0)" ::: "memory");
        } else {
            XB_SPIN(xb_ld(&bar[XB_XGEN(b.x)]) == gen, bar);
            __builtin_amdgcn_fence(__ATOMIC_ACQUIRE, "agent");
            asm volatile("s_waitcnt vmcnt(0)" ::: "memory");
        }
    }
    __syncthreads();
}

constexpr int NWAVES = 8;
constexpr int DM = 2048, DFF = 8192, NCTX = 4096, NLAT = 2048, MTOK = 6144;
constexpr int CSEQ = 256, LSEQ = 1024, PAST = 512, KVL = 1536;
constexpr int MODW = 6 * DM;
constexpr int MODL = 3 * MODW;
constexpr float ALPHA_F = 1.681792830507429f;
constexpr float LN_EPS = 1e-5f, RMS_EPS = 1e-6f;

constexpr size_t OUT_AK = 12582912, OUT_AV = 29360128, OUT_BK = 46137344, OUT_BV = 48234496, OUT_TOTAL = 50331648;

constexpr size_t MiB = 1u << 20;
constexpr size_t WS_CTL = 0, CTL_ZERO_BYTES = 1 * MiB;
constexpr size_t WS_MOD = 1 * MiB;
constexpr size_t WS_ROPE = 2 * MiB;
constexpr size_t WS_WQKVA = 16 * MiB;
constexpr size_t WS_WOA = 64 * MiB;
constexpr size_t WS_WQKVB = 80 * MiB;
constexpr size_t WS_WOB = 92 * MiB;
constexpr size_t WS_WF = 100 * MiB;
constexpr size_t WS_DFTW = 108 * MiB;
constexpr size_t WS_DSCTX = 124 * MiB;
constexpr size_t WS_DSLAT = 126 * MiB;
constexpr size_t WS_WUP = 132 * MiB;
constexpr size_t WS_WDOWN = 260 * MiB;
constexpr size_t WS_KALLA = 388 * MiB;
constexpr size_t WS_VALLA = 412 * MiB;
constexpr size_t WS_KALLB = 436 * MiB;
constexpr size_t WS_VALLB = 440 * MiB;
constexpr size_t WS_X = 444 * MiB;
constexpr size_t WS_H = 492 * MiB;
constexpr size_t WS_U = 540 * MiB;
constexpr size_t WS_Q = 564 * MiB;
constexpr size_t WS_KCTX = 588 * MiB;
constexpr size_t WS_VCTX = 604 * MiB;
constexpr size_t WS_QKTMP = 620 * MiB;
constexpr size_t WS_ORAW = 680 * MiB;
constexpr size_t WS_OB = 776 * MiB;
constexpr size_t WS_HID = 800 * MiB;
constexpr size_t WS_ZCTX = 896 * MiB;
constexpr size_t WS_ZLAT = 928 * MiB;
constexpr size_t WS_END = 944 * MiB;

constexpr int CW_TMO = 0, CW_CODE = 1, CW_BAR = 4096;

constexpr int RING_OFF = 0, RING_BYTES = 131072;
constexpr int LDSCTL_OFF = RING_BYTES, MISC_OFF = LDSCTL_OFF + 320;
constexpr int LDS_BYTES = 147456;

struct Frame {
    LAS unsigned char* lds;
    volatile LAS unsigned* MISC;
    gu32* ctl;
    int wave, vcu, G;
    float* out;
    unsigned char* ws;
};
struct Args { const float* in[23]; float* out; unsigned char* ws; int ph_lo, ph_hi, li, pad; };
typedef __attribute__((address_space(4))) const Args CArgs;
__device__ __forceinline__ const float* in_ptr(int k) { CArgs* a = (CArgs*)__builtin_amdgcn_kernarg_segment_ptr(); asm volatile("" : "+s"(a)); return (const float*)(const GAS float*)a->in[k]; }
template <class T> __device__ __forceinline__ T* wsp(const Frame& F, size_t off) { GAS unsigned char* w = (GAS unsigned char*)F.ws; asm volatile("" : "+s"(w)); return (T*)(w + off); }
__device__ __forceinline__ int lane_id() { return (int)__builtin_amdgcn_mbcnt_hi(~0u, __builtin_amdgcn_mbcnt_lo(~0u, 0u)); }

__device__ __forceinline__ float wave_sum(float v) {
#pragma unroll
    for (int o = 1; o < 64; o <<= 1) v += __shfl_xor(v, o);
    return v;
}
__device__ __forceinline__ unsigned pkbf(float lo, float hi) { return pg8::cvt_pk_bf16(lo, hi); }

namespace att {
using bf16x8 = __attribute__((ext_vector_type(8))) short;
using s16x4  = __attribute__((ext_vector_type(4))) short;
using f32x16 = __attribute__((ext_vector_type(16))) float;
using u32x4  = __attribute__((ext_vector_type(4))) unsigned;
constexpr int D = 128, QBLK = 32, KVBLK = 64;
constexpr float SCALE = 0.088388347648318440f;
constexpr float THR = 8.f;
constexpr int SHM_V = KVBLK * D * 2, SHM_K = KVBLK * D * 2, SHM_ATTN = 2 * SHM_V + 2 * SHM_K + NWAVES * 64 * 4;
#define KSWZ(row, colB) ((row) * 256 + ((colB) ^ (((row) & 7) << 4)))
#define SBAR() __builtin_amdgcn_sched_barrier(0)
__device__ __forceinline__ int crow(int r, int hi) { return (r & 3) + 8 * (r >> 2) + 4 * hi; }
__device__ __forceinline__ unsigned cvtpk(float lo, float hi) { unsigned r; asm volatile("v_cvt_pk_bf16_f32 %0, %1, %2" : "=v"(r) : "v"(lo), "v"(hi)); return r; }

__device__ __forceinline__ void partialSM(f32x16& p0, f32x16& p1, float& m_reg, float& mn, float& alpha) {
  constexpr float C = SCALE * 1.4426950408889634f;
  float pmax = p0[0];
#pragma unroll
  for (int r = 1; r < 16; ++r) pmax = fmaxf(pmax, p0[r]);
#pragma unroll
  for (int r = 0; r < 16; ++r) pmax = fmaxf(pmax, p1[r]);
  { auto rr = __builtin_amdgcn_permlane32_swap(__float_as_uint(pmax), __float_as_uint(pmax), false, false);
    pmax = fmaxf(__uint_as_float(rr[0]), __uint_as_float(rr[1])); }
  if (__builtin_expect(__all(pmax - m_reg <= THR / SCALE), 1)) { mn = m_reg; alpha = 1.f; }
  else { mn = fmaxf(m_reg, pmax); alpha = __builtin_amdgcn_exp2f((m_reg - mn) * C); m_reg = mn; }
  float mnC = -mn * C;
#pragma unroll
  for (int r = 0; r < 16; ++r) p0[r] = fmaf(p0[r], C, mnC);
#pragma unroll
  for (int r = 0; r < 16; ++r) p1[r] = fmaf(p1[r], C, mnC);
#pragma unroll
  for (int r = 0; r < 16; ++r) p0[r] = __builtin_amdgcn_exp2f(p0[r]);
}
__device__ __forceinline__ void finishSM(f32x16& p0, f32x16& p1, float alpha, float& l_reg, bf16x8& pa0, bf16x8& pa1, bf16x8& pa2, bf16x8& pa3) {
#pragma unroll
  for (int r = 0; r < 16; ++r) p1[r] = __builtin_amdgcn_exp2f(p1[r]);
  float ps = 0;
#pragma unroll
  for (int r = 0; r < 16; ++r) ps += p0[r];
#pragma unroll
  for (int r = 0; r < 16; ++r) ps += p1[r];
  { auto rr = __builtin_amdgcn_permlane32_swap(__float_as_uint(ps), __float_as_uint(ps), false, false);
    ps = __uint_as_float(rr[0]) + __uint_as_float(rr[1]); }
  l_reg = l_reg * alpha + ps;
#define PK4(P, BASE, OUT) do { unsigned a0 = cvtpk(P[BASE + 0], P[BASE + 1]), a1 = cvtpk(P[BASE + 2], P[BASE + 3]);   \
    unsigned b0 = cvtpk(P[BASE + 4], P[BASE + 5]), b1 = cvtpk(P[BASE + 6], P[BASE + 7]);                              \
    auto r0 = __builtin_amdgcn_permlane32_swap(a0, b0, false, false); auto r1 = __builtin_amdgcn_permlane32_swap(a1, b1, false, false); \
    u32x4 w = {r0[0], r1[0], r0[1], r1[1]}; OUT = *reinterpret_cast<bf16x8*>(&w); } while (0)
  PK4(p0, 0, pa0); PK4(p0, 8, pa1); PK4(p1, 0, pa2); PK4(p1, 8, pa3);
#undef PK4
}
__device__ __forceinline__ void qkt(f32x16& p0, f32x16& p1, const LAS unsigned char* Ks, const bf16x8* qr, int r32, int hi) {
  p0 = f32x16{}; p1 = f32x16{};
#pragma unroll
  for (int d0 = 0; d0 < 8; ++d0) { int cb = (d0 * 16 + hi * 8) * 2;
    bf16x8 b0 = *reinterpret_cast<const LAS bf16x8*>(Ks + KSWZ(r32, cb));
    bf16x8 b1 = *reinterpret_cast<const LAS bf16x8*>(Ks + KSWZ(32 + r32, cb));
    p0 = __builtin_amdgcn_mfma_f32_32x32x16_bf16(b0, qr[d0], p0, 0, 0, 0);
    p1 = __builtin_amdgcn_mfma_f32_32x32x16_bf16(b1, qr[d0], p1, 0, 0, 0); }
}
__device__ __forceinline__ int v_st(int k, int c) { const int kk = (k & ~0xC) | ((k & 4) << 1) | ((k & 8) >> 1); return ((kk >> 3) * 4 + (c >> 5)) * 512 + ((kk & 7) * 32 + (c & 31)) * 2; }
__device__ __forceinline__ int v_rd_base(int lane) { return ((lane & 3) << 3) | (((lane >> 2) & 3) << 6) | (((lane >> 4) & 1) << 5) | (((lane >> 5) & 1) << 8); }
constexpr int v_rd_off(int d0, int ks, int half) { return d0 * 512 + ks * 4096 + half * 2048; }
template <int OFF> __device__ __forceinline__ s16x4 tr_read(int vb) {
  s16x4 r; asm volatile("ds_read_b64_tr_b16 %0, %1 offset:%2" : "=&v"(r) : "v"(vb), "i"(OFF) : "memory"); return r;
}
template <int D0> __device__ __forceinline__ void pv_one(f32x16& od, int vb, bf16x8 pa0, bf16x8 pa1, bf16x8 pa2, bf16x8 pa3) {
  const s16x4 l0 = tr_read<v_rd_off(D0, 0, 0)>(vb), h0 = tr_read<v_rd_off(D0, 0, 1)>(vb), l1 = tr_read<v_rd_off(D0, 1, 0)>(vb), h1 = tr_read<v_rd_off(D0, 1, 1)>(vb);
  const s16x4 l2 = tr_read<v_rd_off(D0, 2, 0)>(vb), h2 = tr_read<v_rd_off(D0, 2, 1)>(vb), l3 = tr_read<v_rd_off(D0, 3, 0)>(vb), h3 = tr_read<v_rd_off(D0, 3, 1)>(vb);
  asm volatile("s_waitcnt lgkmcnt(0)" ::: "memory"); SBAR();
#define PK(L, H) (bf16x8){L[0], L[1], L[2], L[3], H[0], H[1], H[2], H[3]}
  od = __builtin_amdgcn_mfma_f32_32x32x16_bf16(pa0, PK(l0, h0), od, 0, 0, 0);
  od = __builtin_amdgcn_mfma_f32_32x32x16_bf16(pa1, PK(l1, h1), od, 0, 0, 0);
  od = __builtin_amdgcn_mfma_f32_32x32x16_bf16(pa2, PK(l2, h2), od, 0, 0, 0);
  od = __builtin_amdgcn_mfma_f32_32x32x16_bf16(pa3, PK(l3, h3), od, 0, 0, 0);
#undef PK
}
__device__ __forceinline__ void pv_d0(f32x16* o, int vb, bf16x8 pa0, bf16x8 pa1, bf16x8 pa2, bf16x8 pa3) {
  pv_one<0>(o[0], vb, pa0, pa1, pa2, pa3); pv_one<1>(o[1], vb, pa0, pa1, pa2, pa3); pv_one<2>(o[2], vb, pa0, pa1, pa2, pa3); pv_one<3>(o[3], vb, pa0, pa1, pa2, pa3);
}
template <int LDQ, int LDK, int LDO, bool OF32>
__device__ __forceinline__ void attn_body(const unsigned short* __restrict__ Qb, const unsigned short* __restrict__ Kh, const unsigned short* __restrict__ Vh,
                                          void* __restrict__ Ob, int seq, LAS unsigned char* lds, const int wid  ) {
  const int lane = lane_id(), tid = wid * 64 + lane, r32 = lane & 31, hi = lane >> 5;
  LAS unsigned char* V_lds = lds; LAS unsigned char* K_lds = lds + 2 * SHM_V;
  LAS float* ws = (LAS float*)(lds + 2 * SHM_V + 2 * SHM_K) + wid * 64; LAS float* li_l = ws; LAS float* al_l = ws + 32;
  float m_reg = -1e30f, l_reg = 0; f32x16 o[4] = {}; bf16x8 qr[8];
  { const unsigned qoff = (unsigned)(((wid * QBLK + r32) * LDQ + hi * 8) * 2);
#pragma unroll
    for (int d0 = 0; d0 < 8; ++d0) qr[d0] = *reinterpret_cast<const bf16x8*>((const char*)Qb + qoff + d0 * 32); }
  const int sr = tid >> 4, sc = (tid & 15) * 8, vst0 = v_st(sr, sc), vst1 = v_st(32 + sr, sc);
  const int vb0 = (int)(unsigned)(uintptr_t)V_lds + v_rd_base(lane);
  const unsigned voff = (unsigned)((sr * LDK + sc) * 2);
  struct { bf16x8 vs0, vs1, ks0, ks1; } sr_[2];
#define SLOAD(i, k0) do { const char* vb_ = (const char*)Vh + (size_t)(k0) * (LDK * 2); const char* kb_ = (const char*)Kh + (size_t)(k0) * (LDK * 2); \
    sr_[i].vs0 = *reinterpret_cast<const bf16x8*>(vb_ + voff); sr_[i].vs1 = *reinterpret_cast<const bf16x8*>(vb_ + 32 * LDK * 2 + voff); \
    sr_[i].ks0 = *reinterpret_cast<const bf16x8*>(kb_ + voff); sr_[i].ks1 = *reinterpret_cast<const bf16x8*>(kb_ + 32 * LDK * 2 + voff); } while (0)
#define SWRITE(b, i) do { *(LAS bf16x8*)(V_lds + (b) * SHM_V + vst0) = sr_[i].vs0;          \
    *(LAS bf16x8*)(V_lds + (b) * SHM_V + vst1) = sr_[i].vs1; int kc = sc * 2;               \
    *(LAS bf16x8*)(K_lds + (b) * SHM_K + KSWZ(sr, kc)) = sr_[i].ks0;                       \
    *(LAS bf16x8*)(K_lds + (b) * SHM_K + KSWZ(32 + sr, kc)) = sr_[i].ks1; } while (0)
#define SWAIT() asm volatile("s_waitcnt vmcnt(4)" ::: "memory")
#define RESC(a) do { if (__any((a) < 1.f)) { if (hi == 0) al_l[r32] = (a); asm volatile("s_waitcnt lgkmcnt(0)" ::: "memory"); \
    _Pragma("unroll") for (int d = 0; d < 4; ++d) _Pragma("unroll") for (int r = 0; r < 16; ++r) o[d][r] *= al_l[crow(r, hi)]; } } while (0)
  f32x16 pA0, pA1, pB0, pB1; float mnA, mnB, alA, alB; bf16x8 pa0, pa1, pa2, pa3; const int NT = seq / KVBLK;
  constexpr int SE = 0, SO = 1;
  SLOAD(SE, 0); asm volatile("s_waitcnt vmcnt(0)" ::: "memory"); SWRITE(0, SE); __syncthreads();
  qkt(pA0, pA1, K_lds, qr, r32, hi); partialSM(pA0, pA1, m_reg, mnA, alA);
  SLOAD(SO, KVBLK); if (2 < NT) SLOAD(SE, 2 * KVBLK);
  SWAIT(); SWRITE(1, SO); __syncthreads();
  for (int j = 1; j + 1 < NT; j += 2) {
    SBAR(); qkt(pB0, pB1, K_lds + SHM_K, qr, r32, hi);
    finishSM(pA0, pA1, alA, l_reg, pa0, pa1, pa2, pa3); SBAR();
    SLOAD(SO, (j + 2) * KVBLK); SBAR();
    pv_d0(o, vb0, pa0, pa1, pa2, pa3); partialSM(pB0, pB1, m_reg, mnB, alB);
    __syncthreads(); SWAIT(); SWRITE(0, SE);
    RESC(alB); __syncthreads();
    SBAR(); qkt(pA0, pA1, K_lds, qr, r32, hi);
    finishSM(pB0, pB1, alB, l_reg, pa0, pa1, pa2, pa3); SBAR();
    if (j + 3 < NT) SLOAD(SE, (j + 3) * KVBLK); SBAR();
    pv_d0(o, vb0 + SHM_V, pa0, pa1, pa2, pa3); partialSM(pA0, pA1, m_reg, mnA, alA);
    __syncthreads(); SWAIT(); SWRITE(1, SO);
    RESC(alA); __syncthreads();
  }
  SBAR(); qkt(pB0, pB1, K_lds + SHM_K, qr, r32, hi);
  finishSM(pA0, pA1, alA, l_reg, pa0, pa1, pa2, pa3); SBAR();
  pv_d0(o, vb0, pa0, pa1, pa2, pa3); partialSM(pB0, pB1, m_reg, mnB, alB);
  __syncthreads(); RESC(alB);
  finishSM(pB0, pB1, alB, l_reg, pa0, pa1, pa2, pa3); SBAR();
  pv_d0(o, vb0 + SHM_V, pa0, pa1, pa2, pa3);
  if (hi == 0) li_l[r32] = l_reg; asm volatile("s_waitcnt lgkmcnt(0)" ::: "memory");
  float rli[16];
#pragma unroll
  for (int r = 0; r < 16; ++r) rli[r] = __builtin_amdgcn_rcpf(li_l[crow(r, hi)]);
  int lane_o = lane; asm volatile("" : "+v"(lane_o));
  const int r32o = lane_o & 31, hio = lane_o >> 5;
  if constexpr (OF32) {
    char* Ow = (char*)Ob + (size_t)(wid * QBLK) * (LDO * 4);
#pragma unroll
    for (int r = 0; r < 16; ++r) { const unsigned ooff = (unsigned)((crow(r, hio) * LDO + r32o) * 4);
#pragma unroll
      for (int d0 = 0; d0 < 4; ++d0) *(float*)(Ow + ooff + d0 * 128) = o[d0][r] * rli[r]; }
  } else {
    char* Ow = (char*)Ob + (size_t)(wid * QBLK) * (LDO * 2);
#pragma unroll
    for (int r = 0; r < 16; ++r) { const unsigned ooff = (unsigned)((crow(r, hio) * LDO + r32o) * 2);
#pragma unroll
      for (int d0 = 0; d0 < 4; ++d0) *(unsigned short*)(Ow + ooff + d0 * 64) = (unsigned short)(cvtpk(o[d0][r] * rli[r], 0.f) & 0xffffu); }
  }
  __syncthreads();
#undef SLOAD
#undef SWRITE
#undef SWAIT
#undef RESC
}
#undef KSWZ
#undef SBAR
}

struct RouterQkvA {
    unsigned short *Q, *Kctx, *Vctx, *Vall; float *QKtmp, *outK, *outV;
    __device__ __forceinline__ pg8::Route operator()(const pg8::Unit& u) const {
        pg8::Route rt; rt.ob = nullptr; rt.of = nullptr; rt.ldb = DM; rt.ldf = DM;
        const int sect = u.pn >> 3, col0 = (u.pn & 7) * 256;
        if (u.pm < 16) { const size_t rb = (size_t)u.pm * 256;
            if (sect == 0) rt.ob = Q + rb * DM + col0;
            else if (sect == 1) { rt.ob = Kctx + rb * DM + col0; rt.of = outK + (size_t)u.pm * (2 * 256 * DM) + col0; }
            else { rt.ob = Vctx + rb * DM + col0; rt.of = outV + (size_t)u.pm * (2 * 256 * DM) + col0; }
        } else { const int lt = u.pm - 16, b = lt >> 2, s0 = (lt & 3) * 256;
            if (sect == 0) { rt.of = QKtmp + (size_t)lt * 256 * 4096 + col0; rt.ldf = 4096; }
            else if (sect == 1) { rt.of = QKtmp + (size_t)lt * 256 * 4096 + 2048 + col0; rt.ldf = 4096; }
            else rt.ob = Vall + ((size_t)b * KVL + PAST + s0) * DM + col0;
        }
        return rt;
    }
};
struct RouterQkvB {
    unsigned short *Vctx, *Vall; float *QKtmp, *outV;
    __device__ __forceinline__ pg8::Route operator()(const pg8::Unit& u) const {
        pg8::Route rt; rt.ob = nullptr; rt.of = nullptr; rt.ldb = 512; rt.ldf = 2560;
        const size_t rb = (size_t)u.pm * 256;
        if (u.pn < 10) { rt.of = QKtmp + rb * 2560 + u.pn * 256; }
        else { const int c0 = (u.pn - 10) * 256;
            if (u.pm < 16) { rt.ob = Vctx + rb * 512 + c0; rt.of = outV + rb * 512 + c0; rt.ldf = 512; }
            else { const int lt = u.pm - 16, b = lt >> 2, s0 = (lt & 3) * 256; rt.ob = Vall + ((size_t)b * KVL + PAST + s0) * 512 + c0; }
        }
        return rt;
    }
};
struct RouterDft1 {
    unsigned short *Zctx, *Zlat;
    __device__ __forceinline__ pg8::Route operator()(const pg8::Unit& u) const {
        pg8::Route rt; rt.of = nullptr; rt.ldf = 0;
        const int part = u.pm >> 3, col0 = (u.pm & 7) * 256;
        if (u.pn < 16) { rt.ob = Zctx + ((size_t)u.pn * DM + col0) * 512 + part * 256; rt.ldb = 512; }
        else { const int lt = u.pn - 16, b = lt >> 2, p0 = (lt & 3) * 256; rt.ob = Zlat + ((size_t)b * DM + col0) * 2048 + part * 1024 + p0; rt.ldb = 2048; }
        return rt;
    }
};
struct RouterDft2Ctx {
    unsigned short* Y;
    __device__ __forceinline__ pg8::Route operator()(const pg8::Unit& u) const {
        pg8::Route rt; rt.of = nullptr; rt.ldf = 0; rt.ldb = DM;
        const int b = u.pn >> 3, col0 = (u.pn & 7) * 256; rt.ob = Y + (size_t)(b * 256) * DM + col0; return rt;
    }
};
struct RouterDft2Lat {
    unsigned short* Y;
    __device__ __forceinline__ pg8::Route operator()(const pg8::Unit& u) const {
        pg8::Route rt; rt.of = nullptr; rt.ldf = 0; rt.ldb = DM;
        const int b = u.pn >> 3, col0 = (u.pn & 7) * 256; rt.ob = Y + (size_t)(NCTX + b * LSEQ + u.pm * 256) * DM + col0; return rt;
    }
};

__device__ __forceinline__ void transpose_item(const float* W, int K, int N, unsigned short* WT, int item, int lane) {
    const int nblk = N >> 8, kb = item / nblk, nb = item - kb * nblk, k0 = kb * 64, n = nb * 256 + 4 * lane;
    const float* src = W + (size_t)k0 * N + n;
    unsigned short* dst = WT + (size_t)n * K + k0;
#pragma unroll
    for (int h = 0; h < 2; ++h) {
        f32x4 v[32];
#pragma unroll
        for (int i = 0; i < 32; ++i) v[i] = __builtin_nontemporal_load((const f32x4*)(src + (size_t)(h * 32 + i) * N));
#pragma unroll
        for (int j = 0; j < 4; ++j)
#pragma unroll
            for (int g = 0; g < 4; ++g) { v4u o; o.x = pkbf(v[8 * g][j], v[8 * g + 1][j]); o.y = pkbf(v[8 * g + 2][j], v[8 * g + 3][j]); o.z = pkbf(v[8 * g + 4][j], v[8 * g + 5][j]); o.w = pkbf(v[8 * g + 6][j], v[8 * g + 7][j]);
                *(v4u*)(dst + (size_t)j * K + h * 32 + 8 * g) = o; }
    }
}
__device__ __forceinline__ void transpose_job(const float* W, int K, int N, unsigned short* WT, int w, int NW, int lane) {
    const int nitems = (K >> 6) * (N >> 8);
    for (int it = w; it < nitems; it += NW) transpose_item(W, K, N, WT, it, lane);
}
__device__ __forceinline__ void cvt_row(const float* src, unsigned short* dst, int n, int lane) {
    for (int i = lane * 8; i < n; i += 512) { const f32x4 a = *(const f32x4*)(src + i), b = *(const f32x4*)(src + i + 4);
        v4u o; o.x = pkbf(a.x, a.y); o.y = pkbf(a.z, a.w); o.z = pkbf(b.x, b.y); o.w = pkbf(b.z, b.w); *(v4u*)(dst + i) = o; }
}
__device__ __forceinline__ float dftw_val(int j, int c) {
    const int part = j >> 11, col = j & 2047, g = col >> 9, ko = col & 511, gin = c >> 9, n = c & 511;
    if (gin != g) return 0.f;
    const float x = (float)((ko * n) & 511) * (1.0f / 256.0f);
    return (part ? sinpif(x) : cospif(x)) * 0.04419417382415922f;
}
__device__ __forceinline__ float dsctx_val(int pos, int kk) {
    const int k = kk & 255; const float x = (float)((pos * k) & 255) * (1.0f / 128.0f);
    return (kk < 256 ? cospif(x) : -sinpif(x)) * 0.0625f;
}
__device__ __forceinline__ float dslat_val(int pos, int kk) {
    const int k = kk & 1023; const float x = (float)((pos * k) & 1023) * (1.0f / 512.0f);
    return (kk < 1024 ? cospif(x) : -sinpif(x)) * 0.03125f;
}
__device__ __forceinline__ float silu_f(float x) { return x / (1.0f + __expf(-x)); }
__device__ __forceinline__ void silu_table(Frame& F, LAS float* tab) {
    const int tid = F.wave * 64 + lane_id();
    for (int i = tid; i < 3 * DM; i += NWAVES * 64) { const int r = i >> 11, k = i & 2047; const float x = (r == 0) ? in_ptr(7)[k] : in_ptr(6)[(size_t)(r - 1) * DM + k]; tab[i] = silu_f(x); }
    __syncthreads();
}
__device__ __forceinline__ void gemv_item(Frame& F, const LAS float* tab, int l, int chunk, int lane) {
    const int cg = lane & 7, kq = lane >> 3, col = chunk * 32 + cg * 4;
    const float* wp = in_ptr(8) + ((size_t)l * DM + kq) * MODW + col;
    f32x4 a0 = {0.f, 0.f, 0.f, 0.f}, a1 = a0, a2 = a0;
#pragma unroll 16
    for (int kk = 0; kk < DM / 8; ++kk) { const f32x4 w = __builtin_nontemporal_load((const f32x4*)(wp + (size_t)kk * 8 * MODW)); const int k = kk * 8 + kq;
        a0 += w * tab[k]; a1 += w * tab[DM + k]; a2 += w * tab[2 * DM + k]; }
#pragma unroll
    for (int o = 8; o < 64; o <<= 1) {
#pragma unroll
        for (int e = 0; e < 4; ++e) { a0[e] += __shfl_xor(a0[e], o); a1[e] += __shfl_xor(a1[e], o); a2[e] += __shfl_xor(a2[e], o); } }
    if (kq == 0) { const f32x4 bias = *(const f32x4*)(in_ptr(9) + (size_t)l * MODW + col); float* d = wsp<float>(F, WS_MOD) + (size_t)l * MODL + col;
        *(f32x4*)d = a0 + bias; *(f32x4*)(d + MODW) = a1 + bias; *(f32x4*)(d + 2 * MODW) = a2 + bias; }
}
template <int L> __device__ __forceinline__ void layer_prep(Frame& F, int part, int w, int NW) {
    const int lane = lane_id();
    if (part == 0) {
        LAS float* tab = (LAS float*)(F.lds + RING_OFF);
        silu_table(F, tab);
        for (int it = w; it < MODW / 32; it += NW) gemv_item(F, tab, L, it, lane);
        __syncthreads();
    } else {
        if constexpr (L == 0) { transpose_job(in_ptr(14), DM, 6144, wsp<unsigned short>(F, WS_WQKVA), w, NW, lane); transpose_job(in_ptr(15), DM, DM, wsp<unsigned short>(F, WS_WOA), w, NW, lane); }
        if constexpr (L == 1) { transpose_job(in_ptr(18), DM, 3072, wsp<unsigned short>(F, WS_WQKVB), w, NW, lane); transpose_job(in_ptr(19), DM, DM, wsp<unsigned short>(F, WS_WOB), w, NW, lane); }
        if constexpr (L == 2) { transpose_job(in_ptr(22), DM, DM, wsp<unsigned short>(F, WS_WF), w, NW, lane); }
        if constexpr (L == 3) { transpose_job(in_ptr(14) + (size_t)DM * 6144, DM, 6144, wsp<unsigned short>(F, WS_WQKVA) + (size_t)6144 * DM, w, NW, lane);
                                transpose_job(in_ptr(15) + (size_t)DM * DM, DM, DM, wsp<unsigned short>(F, WS_WOA) + (size_t)DM * DM, w, NW, lane); }
        transpose_job(in_ptr(12) + (size_t)L * DM * DFF, DM, DFF, wsp<unsigned short>(F, WS_WUP) + (size_t)L * DFF * DM, w, NW, lane);
        transpose_job(in_ptr(13) + (size_t)L * DFF * DM, DFF, DM, wsp<unsigned short>(F, WS_WDOWN) + (size_t)L * DM * DFF, w, NW, lane);
    }
}
template <int L> __device__ __forceinline__ void layer_prep_bg(Frame& F, int part) {
    const int c = (int)blockIdx.x, G = F.G;
    if (G > 192) { if (c >= 192) layer_prep<L>(F, part, F.wave * (G - 192) + (c - 192), (G - 192) * NWAVES); }
    else layer_prep<L>(F, part, F.wave * G + c, G * NWAVES);
}

__device__ __forceinline__ void p0_prologue(Frame& F) {
    const int gw = F.vcu * NWAVES + F.wave, NGW = F.G * NWAVES, lane = lane_id();
    layer_prep<0>(F, 0, F.wave * F.G + F.vcu, NGW);
    layer_prep<0>(F, 1, F.wave * F.G + F.vcu, NGW);
    for (int it = gw; it < 6144; it += NGW) {
        if (it < 4096) { const int isv = it >> 11, r = it & 2047, b = r >> 10, j = (r >> 9) & 1, t = r & 511;
            cvt_row((isv ? in_ptr(3) : in_ptr(2)) + (size_t)r * DM, wsp<unsigned short>(F, isv ? WS_VALLA : WS_KALLA) + ((size_t)(j * 2 + b) * KVL + t) * DM, DM, lane); }
        else { const int q = it - 4096, isv = q >> 10, r = q & 1023, b = r >> 9, t = r & 511;
            cvt_row((isv ? in_ptr(5) : in_ptr(4)) + (size_t)r * 512, wsp<unsigned short>(F, isv ? WS_VALLB : WS_KALLB) + ((size_t)b * KVL + t) * 512, 512, lane); }
    }
    for (int it = gw; it < 4096 + 256 + 1024; it += NGW) {
        if (it < 4096) { unsigned short* d = wsp<unsigned short>(F, WS_DFTW) + (size_t)it * DM;
            for (int c0 = lane * 8; c0 < DM; c0 += 512) { v4u o; o.x = pkbf(dftw_val(it, c0), dftw_val(it, c0 + 1)); o.y = pkbf(dftw_val(it, c0 + 2), dftw_val(it, c0 + 3)); o.z = pkbf(dftw_val(it, c0 + 4), dftw_val(it, c0 + 5)); o.w = pkbf(dftw_val(it, c0 + 6), dftw_val(it, c0 + 7)); *(v4u*)(d + c0) = o; } }
        else if (it < 4096 + 256) { const int pos = it - 4096; unsigned short* d = wsp<unsigned short>(F, WS_DSCTX) + (size_t)pos * 512;
            { const int c0 = lane * 8; v4u o; o.x = pkbf(dsctx_val(pos, c0), dsctx_val(pos, c0 + 1)); o.y = pkbf(dsctx_val(pos, c0 + 2), dsctx_val(pos, c0 + 3)); o.z = pkbf(dsctx_val(pos, c0 + 4), dsctx_val(pos, c0 + 5)); o.w = pkbf(dsctx_val(pos, c0 + 6), dsctx_val(pos, c0 + 7)); *(v4u*)(d + c0) = o; } }
        else { const int pos = it - 4096 - 256; unsigned short* d = wsp<unsigned short>(F, WS_DSLAT) + (size_t)pos * 2048;
            for (int c0 = lane * 8; c0 < 2048; c0 += 512) { v4u o; o.x = pkbf(dslat_val(pos, c0), dslat_val(pos, c0 + 1)); o.y = pkbf(dslat_val(pos, c0 + 2), dslat_val(pos, c0 + 3)); o.z = pkbf(dslat_val(pos, c0 + 4), dslat_val(pos, c0 + 5)); o.w = pkbf(dslat_val(pos, c0 + 6), dslat_val(pos, c0 + 7)); *(v4u*)(d + c0) = o; } }
    }
    for (int it = gw; it < 32; it += NGW) { const int e = it * 64 + lane, pos = e >> 5, f = e & 31;
        const float inv = powf(10000.0f, -(float)f / 32.0f), ang = (float)pos * inv;
        float* d = wsp<float>(F, WS_ROPE) + 2 * e; d[0] = cosf(ang); d[1] = sinf(ang); }
}
__device__ __forceinline__ int cond_of_row(int row) { return row < NCTX ? 0 : 1 + ((row - NCTX) >> 10); }
__device__ __forceinline__ void p_modulate0(Frame& F) {
    const int gw = F.vcu * NWAVES + F.wave, NGW = F.G * NWAVES, lane = lane_id();
    for (int row = gw; row < MTOK; row += NGW) {
        const float* xp = row < NCTX ? in_ptr(0) + (size_t)row * DM : in_ptr(1) + (size_t)(row - NCTX) * DM;
        const float* md = wsp<float>(F, WS_MOD) + (size_t)cond_of_row(row) * MODW;
        float* xo = wsp<float>(F, WS_X) + (size_t)row * DM; unsigned short* uo = wsp<unsigned short>(F, WS_U) + (size_t)row * DM;
#pragma unroll
        for (int j = 0; j < 8; ++j) { const int c = 4 * lane + 256 * j; const f32x4 x = *(const f32x4*)(xp + c), sh = *(const f32x4*)(md + c), sc = *(const f32x4*)(md + DM + c);
            *(f32x4*)(xo + c) = x; const f32x4 u = x * (sc + 1.0f) + sh;
            *(unsigned long long*)(uo + c) = (unsigned long long)pkbf(u.x, u.y) | ((unsigned long long)pkbf(u.z, u.w) << 32); }
    }
}
__device__ __forceinline__ void p_layernorm(Frame& F, const float* g, const float* bta, float* xout, const float* mdn, int shi, int sci) {
    const int gw = F.vcu * NWAVES + F.wave, NGW = F.G * NWAVES, lane = lane_id();
    for (int row = gw; row < MTOK; row += NGW) {
        const float* hp = wsp<float>(F, WS_H) + (size_t)row * DM;
        f32x4 v[8]; float s = 0.f;
#pragma unroll
        for (int j = 0; j < 8; ++j) { v[j] = *(const f32x4*)(hp + 4 * lane + 256 * j); s += (v[j].x + v[j].y) + (v[j].z + v[j].w); }
        const float mean = wave_sum(s) * (1.0f / DM); float q = 0.f;
#pragma unroll
        for (int j = 0; j < 8; ++j) { v[j] = v[j] - mean; q += (v[j].x * v[j].x + v[j].y * v[j].y) + (v[j].z * v[j].z + v[j].w * v[j].w); }
        const float rstd = 1.0f / sqrtf(wave_sum(q) * (1.0f / DM) + LN_EPS);
        float* xo = xout + (size_t)row * DM; unsigned short* uo = wsp<unsigned short>(F, WS_U) + (size_t)row * DM;
        const float* md = mdn ? mdn + (size_t)cond_of_row(row) * MODW : nullptr;
#pragma unroll
        for (int j = 0; j < 8; ++j) { const int c = 4 * lane + 256 * j; const f32x4 y = v[j] * rstd * *(const f32x4*)(g + c) + *(const f32x4*)(bta + c);
            *(f32x4*)(xo + c) = y;
            if (md) { const f32x4 u = y * (*(const f32x4*)(md + sci * DM + c) + 1.0f) + *(const f32x4*)(md + shi * DM + c);
                *(unsigned long long*)(uo + c) = (unsigned long long)pkbf(u.x, u.y) | ((unsigned long long)pkbf(u.z, u.w) << 32); } }
    }
}
__device__ __forceinline__ unsigned short bf1(float x) { return (unsigned short)(pkbf(x, 0.f) & 0xffffu); }
__device__ __forceinline__ void p_rope_a(Frame& F, unsigned short* Kall) {
    const int gw = F.vcu * NWAVES + F.wave, NGW = F.G * NWAVES, lane = lane_id(), axis = lane >> 5, f = lane & 31;
    for (int lr = gw; lr < NLAT; lr += NGW) { const int b = lr >> 10, s = lr & 1023, pos = axis ? (s & 63) : (s >> 6);
        const float cs = wsp<float>(F, WS_ROPE)[2 * (pos * 32 + f)], sn = wsp<float>(F, WS_ROPE)[2 * (pos * 32 + f) + 1];
        const float* src = wsp<float>(F, WS_QKTMP) + (size_t)lr * 4096 + axis * 64 + f;
        unsigned short* qd = wsp<unsigned short>(F, WS_Q) + (size_t)(NCTX + lr) * DM + axis * 64 + f;
        unsigned short* kd = Kall + ((size_t)b * KVL + PAST + s) * DM + axis * 64 + f;
#pragma unroll 8
        for (int c = 0; c < 32; ++c) { const float x1 = src[c * 128], x2 = src[c * 128 + 32]; const float o1 = x1 * cs - x2 * sn, o2 = x1 * sn + x2 * cs;
            unsigned short* d = c < 16 ? qd + c * 128 : kd + (c - 16) * 128; d[0] = bf1(o1); d[32] = bf1(o2); }
    }
}
__device__ __forceinline__ void p_norm_rope_b(Frame& F) {
    const int gw = F.vcu * NWAVES + F.wave, NGW = F.G * NWAVES, lane = lane_id(), axis = lane >> 5, f = lane & 31, dd = axis * 64 + f;
    const float gq1 = in_ptr(20)[dd], gq2 = in_ptr(20)[dd + 32], gk1 = in_ptr(21)[dd], gk2 = in_ptr(21)[dd + 32];
    for (int row = gw; row < MTOK; row += NGW) { const bool lat = row >= NCTX; const int lr = row - NCTX, b = lr >> 10, s = lr & 1023, pos = axis ? (s & 63) : (s >> 6);
        float cs = 1.f, sn = 0.f; if (lat) { cs = wsp<float>(F, WS_ROPE)[2 * (pos * 32 + f)]; sn = wsp<float>(F, WS_ROPE)[2 * (pos * 32 + f) + 1]; }
        const float* src = wsp<float>(F, WS_QKTMP) + (size_t)row * 2560 + dd;
        unsigned short* qd = wsp<unsigned short>(F, WS_Q) + (size_t)row * DM + dd;
#pragma unroll 4
        for (int c = 0; c < 20; ++c) { float x1 = src[c * 128], x2 = src[c * 128 + 32];
            const float rs = 1.0f / sqrtf(wave_sum(x1 * x1 + x2 * x2) * (1.0f / 128.0f) + RMS_EPS);
            x1 *= rs * (c < 16 ? gq1 : gk1); x2 *= rs * (c < 16 ? gq2 : gk2);
            const float o1 = x1 * cs - x2 * sn, o2 = x1 * sn + x2 * cs;
            if (c < 16) { qd[c * 128] = bf1(o1); qd[c * 128 + 32] = bf1(o2); }
            else { const int kh = c - 16;
                if (!lat) { unsigned short* kd = wsp<unsigned short>(F, WS_KCTX) + (size_t)row * 512 + kh * 128 + dd; kd[0] = bf1(o1); kd[32] = bf1(o2);
                    float* ko = F.out + OUT_BK + (size_t)row * 512 + kh * 128 + dd; ko[0] = o1; ko[32] = o2; }
                else { unsigned short* kd = wsp<unsigned short>(F, WS_KALLB) + ((size_t)b * KVL + PAST + s) * 512 + kh * 128 + dd; kd[0] = bf1(o1); kd[32] = bf1(o2); } } }
    }
}
__device__ __forceinline__ void p_combine_a(Frame& F, int j, float lam_init) {
    const int gw = F.vcu * NWAVES + F.wave, NGW = F.G * NWAVES, lane = lane_id();
    const float* lp = in_ptr(16) + (size_t)j * 512;
    const float s1 = wave_sum(lp[lane] * lp[128 + lane] + lp[64 + lane] * lp[192 + lane]), s2 = wave_sum(lp[256 + lane] * lp[384 + lane] + lp[320 + lane] * lp[448 + lane]);
    const float lam = expf(s1) - expf(s2) + lam_init;
    const f32x4 g = *(const f32x4*)(in_ptr(17) + (size_t)j * 256 + 4 * lane) * (1.0f - lam_init);
    for (int row = gw; row < MTOK; row += NGW) { const float* op = wsp<float>(F, WS_ORAW) + (size_t)row * 4096 + 4 * lane; unsigned short* od = wsp<unsigned short>(F, WS_OB) + (size_t)row * DM + 4 * lane;
#pragma unroll
        for (int h = 0; h < 8; ++h) { const f32x4 o0 = *(const f32x4*)(op + h * 512), o1 = *(const f32x4*)(op + h * 512 + 256); const f32x4 o = o0 - o1 * lam;
            const float rs = 1.0f / sqrtf(wave_sum((o.x * o.x + o.y * o.y) + (o.z * o.z + o.w * o.w)) * (1.0f / 256.0f) + RMS_EPS);
            const f32x4 y = o * rs * g;
            *(unsigned long long*)(od + h * 256) = (unsigned long long)pkbf(y.x, y.y) | ((unsigned long long)pkbf(y.z, y.w) << 32); }
    }
}
__device__ __forceinline__ void p_attn_a(Frame& F, int j) {
    const unsigned short* Q = wsp<unsigned short>(F, WS_Q); const unsigned short* Kc = wsp<unsigned short>(F, WS_KCTX); const unsigned short* Vc = wsp<unsigned short>(F, WS_VCTX);
    const unsigned short* Ka = wsp<unsigned short>(F, WS_KALLA) + (size_t)j * 2 * KVL * DM; const unsigned short* Va = wsp<unsigned short>(F, WS_VALLA) + (size_t)j * 2 * KVL * DM;
    float* O = wsp<float>(F, WS_ORAW);
    for (int it = F.vcu; it < 768; it += F.G) {
        const unsigned short *q, *k, *v; float* o; int seq;
        if (it < 256) { const int u = it, vh = u & 1, p = (u >> 1) & 1, qb = (u >> 2) & 3, h = (u >> 4) & 7, b = u >> 7; const size_t row0 = (size_t)NCTX + b * LSEQ + qb * 256;
            q = Q + row0 * DM + h * 256 + p * 128; k = Ka + (size_t)b * KVL * DM + h * 256 + p * 128; v = Va + (size_t)b * KVL * DM + h * 256 + vh * 128; o = O + row0 * 4096 + (h * 2 + p) * 256 + vh * 128; seq = KVL; }
        else { const int u = it - 256, vh = u & 1, p = (u >> 1) & 1, h = (u >> 2) & 7, b = u >> 5; const size_t row0 = (size_t)b * CSEQ;
            q = Q + row0 * DM + h * 256 + p * 128; k = Kc + row0 * DM + h * 256 + p * 128; v = Vc + row0 * DM + h * 256 + vh * 128; o = O + row0 * 4096 + (h * 2 + p) * 256 + vh * 128; seq = CSEQ; }
        att::attn_body<DM, DM, 4096, true>(q, k, v, o, seq, F.lds + RING_OFF, F.wave);
    }
}
__device__ __forceinline__ void p_attn_b(Frame& F) {
    const unsigned short* Q = wsp<unsigned short>(F, WS_Q); const unsigned short* Kc = wsp<unsigned short>(F, WS_KCTX); const unsigned short* Vc = wsp<unsigned short>(F, WS_VCTX);
    const unsigned short* Ka = wsp<unsigned short>(F, WS_KALLB); const unsigned short* Va = wsp<unsigned short>(F, WS_VALLB);
    unsigned short* O = wsp<unsigned short>(F, WS_OB);
    for (int it = F.vcu; it < 384; it += F.G) {
        const unsigned short *q, *k, *v; unsigned short* o; int seq;
        if (it >= 128 && it < 256) { const int u = it - 128, qb = u & 3, hq = (u >> 2) & 15, b = u >> 6; const size_t row0 = (size_t)NCTX + b * LSEQ + qb * 256;
            q = Q + row0 * DM + hq * 128; k = Ka + (size_t)b * KVL * 512 + (hq >> 2) * 128; v = Va + (size_t)b * KVL * 512 + (hq >> 2) * 128; o = O + row0 * DM + hq * 128; seq = KVL; }
        else { const int u = it < 128 ? it : it - 128, hq = u & 15, b = u >> 4; const size_t row0 = (size_t)b * CSEQ;
            q = Q + row0 * DM + hq * 128; k = Kc + row0 * 512 + (hq >> 2) * 128; v = Vc + row0 * 512 + (hq >> 2) * 128; o = O + row0 * DM + hq * 128; seq = CSEQ; }
        att::attn_body<DM, 512, DM, false>(q, k, v, o, seq, F.lds + RING_OFF, F.wave);
    }
}

#ifndef MK_PER_PHASE
#define MK_PER_PHASE 0
#endif
constexpr int N_PHASES = 35;
#ifndef MK_PROBE
#define MK_PROBE -1
#endif
enum { C_PRO = 0, C_GEMM = 1, C_ATT = 2, C_LN = 3, C_THIN = 4, C_GEMM_MLP = 5, C_DOWN = 6, C_QKV = 7, C_WO = 8, C_DFT = 10 };
#define PH_IN(k) (lo <= (k) && (k) < hi)
#define PH_END(k) do { if (PH_IN(k) && PH_IN((k) + 1)) { xcd_barrier(bar, F.wave); if (MK_PROBE == 9) xcd_barrier(bar, F.wave); } } while (0)
#define PHASE(k, CLS, ...) do { if (PH_IN(k)) { { __VA_ARGS__ } if (MK_PROBE == (CLS)) { xcd_barrier(bar, F.wave); { __VA_ARGS__ } } } } while (0)

template <class Epi> __device__ __forceinline__ void run_gemm(Frame& F, const unsigned short* A, const unsigned short* Bt, int M, int N, int K, const Epi& E, int c) {
    if (c < 0) return;
    pg8::Gemm g{A, Bt, M, N, K}; pg8::StaticOrder S; S.init(M, N, F.G, c);
    pg8::gemm_phase<Epi, pg8::StaticOrder, true, true>(F.lds + RING_OFF, g, S, E, F.wave);
}
template <int L, int P> __device__ __forceinline__ void mlp_half(Frame& F, const XcdBarrier& bar, int lo, int hi) {
    PHASE(P, C_LN, p_layernorm(F, in_ptr(10) + (size_t)(L * 2 + 0) * DM, in_ptr(11) + (size_t)(L * 2 + 0) * DM, wsp<float>(F, WS_X), wsp<float>(F, WS_MOD) + (size_t)L * MODL, 3, 4););
    PH_END(P);
    PHASE(P + 1, C_GEMM_MLP, pg8::EpiRelu2 E{wsp<unsigned short>(F, WS_HID), DFF};
        run_gemm(F, wsp<unsigned short>(F, WS_U), wsp<unsigned short>(F, WS_WUP) + (size_t)L * DFF * DM, MTOK, DFF, DM, E, (int)blockIdx.x););
    PH_END(P + 1);
    PHASE(P + 2, C_DOWN, pg8::EpiResid E{wsp<float>(F, WS_X), wsp<float>(F, WS_H), wsp<float>(F, WS_MOD) + (size_t)L * MODL + 5 * DM, DM, MODW, ALPHA_F};
        run_gemm(F, wsp<unsigned short>(F, WS_HID), wsp<unsigned short>(F, WS_WDOWN) + (size_t)L * DM * DFF, MTOK, DM, DFF, E, (int)blockIdx.x);
        if constexpr (L < 3) layer_prep_bg<L + 1>(F, 1););
    PH_END(P + 2);
    PHASE(P + 3, C_LN,
        if constexpr (L < 3) p_layernorm(F, in_ptr(10) + (size_t)(L * 2 + 1) * DM, in_ptr(11) + (size_t)(L * 2 + 1) * DM, wsp<float>(F, WS_X), wsp<float>(F, WS_MOD) + (size_t)(L + 1) * MODL, 0, 1);
        else p_layernorm(F, in_ptr(10) + (size_t)(L * 2 + 1) * DM, in_ptr(11) + (size_t)(L * 2 + 1) * DM, F.out, nullptr, 0, 1););
    if constexpr (L < 3) PH_END(P + 3);
}
template <int L, int J, int P> __device__ __forceinline__ void mixer_a(Frame& F, const XcdBarrier& bar, int lo, int hi) {
    constexpr float LAM_INIT = (L == 0) ? 0.2f : 0.5560582044f;
    PHASE(P, C_QKV, pg8::EpiRoute<RouterQkvA> E{{wsp<unsigned short>(F, WS_Q), wsp<unsigned short>(F, WS_KCTX), wsp<unsigned short>(F, WS_VCTX), wsp<unsigned short>(F, WS_VALLA) + (size_t)J * 2 * KVL * DM,
                                                  wsp<float>(F, WS_QKTMP), F.out + OUT_AK + (size_t)J * 256 * DM, F.out + OUT_AV + (size_t)J * 256 * DM}};
        run_gemm(F, wsp<unsigned short>(F, WS_U), wsp<unsigned short>(F, WS_WQKVA) + (size_t)J * 6144 * DM, MTOK, 6144, DM, E, (int)blockIdx.x););
    PH_END(P);
    PHASE(P + 1, C_THIN, p_rope_a(F, wsp<unsigned short>(F, WS_KALLA) + (size_t)J * 2 * KVL * DM););
    PH_END(P + 1);
    PHASE(P + 2, C_ATT, p_attn_a(F, J););
    PH_END(P + 2);
    PHASE(P + 3, C_THIN, p_combine_a(F, J, LAM_INIT););
    PH_END(P + 3);
    PHASE(P + 4, C_WO, pg8::EpiResid E{wsp<float>(F, WS_X), wsp<float>(F, WS_H), wsp<float>(F, WS_MOD) + (size_t)L * MODL + 2 * DM, DM, MODW, ALPHA_F};
        run_gemm(F, wsp<unsigned short>(F, WS_OB), wsp<unsigned short>(F, WS_WOA) + (size_t)J * DM * DM, MTOK, DM, DM, E, (int)blockIdx.x);
        if constexpr (L < 3) layer_prep_bg<L + 1>(F, 0););
    PH_END(P + 4);
}
template <int L, int P> __device__ __forceinline__ void mixer_b(Frame& F, const XcdBarrier& bar, int lo, int hi) {
    PHASE(P, C_QKV, pg8::EpiRoute<RouterQkvB> E{{wsp<unsigned short>(F, WS_VCTX), wsp<unsigned short>(F, WS_VALLB), wsp<float>(F, WS_QKTMP), F.out + OUT_BV}};
        run_gemm(F, wsp<unsigned short>(F, WS_U), wsp<unsigned short>(F, WS_WQKVB), MTOK, 3072, DM, E, (int)blockIdx.x););
    PH_END(P);
    PHASE(P + 1, C_THIN, p_norm_rope_b(F););
    PH_END(P + 1);
    PHASE(P + 2, C_ATT, p_attn_b(F););
    PH_END(P + 2);
    PHASE(P + 3, C_WO, pg8::EpiResid E{wsp<float>(F, WS_X), wsp<float>(F, WS_H), wsp<float>(F, WS_MOD) + (size_t)L * MODL + 2 * DM, DM, MODW, ALPHA_F};
        run_gemm(F, wsp<unsigned short>(F, WS_OB), wsp<unsigned short>(F, WS_WOB), MTOK, DM, DM, E, (int)blockIdx.x);
        layer_prep_bg<L + 1>(F, 0););
    PH_END(P + 3);
}
template <int L, int P> __device__ __forceinline__ void mixer_c(Frame& F, const XcdBarrier& bar, int lo, int hi) {
    PHASE(P, C_DFT, pg8::EpiRoute<RouterDft1> E{{wsp<unsigned short>(F, WS_ZCTX), wsp<unsigned short>(F, WS_ZLAT)}};
        run_gemm(F, wsp<unsigned short>(F, WS_DFTW), wsp<unsigned short>(F, WS_U), 4096, MTOK, DM, E, (int)blockIdx.x););
    PH_END(P);
    PHASE(P + 1, C_DFT,
        { pg8::EpiRoute<RouterDft2Lat> E{{wsp<unsigned short>(F, WS_OB)}};
          run_gemm(F, wsp<unsigned short>(F, WS_DSLAT), wsp<unsigned short>(F, WS_ZLAT), 1024, 4096, 2048, E, (int)blockIdx.x); }
        { pg8::EpiRoute<RouterDft2Ctx> E{{wsp<unsigned short>(F, WS_OB)}};
          run_gemm(F, wsp<unsigned short>(F, WS_DSCTX), wsp<unsigned short>(F, WS_ZCTX), 256, 32768, 512, E, (int)blockIdx.x - 64); });
    PH_END(P + 1);
    PHASE(P + 2, C_WO, pg8::EpiResid E{wsp<float>(F, WS_X), wsp<float>(F, WS_H), wsp<float>(F, WS_MOD) + (size_t)L * MODL + 2 * DM, DM, MODW, ALPHA_F};
        run_gemm(F, wsp<unsigned short>(F, WS_OB), wsp<unsigned short>(F, WS_WF), MTOK, DM, DM, E, (int)blockIdx.x);
        layer_prep_bg<L + 1>(F, 0););
    PH_END(P + 2);
}

__global__ void __launch_bounds__(NWAVES * 64, 2) mk_fwd(Args args) {
    extern __shared__ __attribute__((aligned(16))) unsigned char lds[];
    Frame F;
    F.lds = (LAS unsigned char*)lds;
    F.MISC = (volatile LAS unsigned*)(F.lds + MISC_OFF);
    F.wave = __builtin_amdgcn_readfirstlane((int)threadIdx.x >> 6);
    F.G = gridDim.x; { const int bx = blockIdx.x; F.vcu = (F.G % 8 == 0) ? (bx % 8) * (F.G / 8) + bx / 8 : bx; }
    F.out = args.out; F.ws = args.ws; F.ctl = (gu32*)(args.ws + WS_CTL);
    for (int u = (int)threadIdx.x; u < (LDS_BYTES - LDSCTL_OFF) / 4; u += NWAVES * 64) ((LAS unsigned*)(F.lds + LDSCTL_OFF))[u] = 0u;
    __syncthreads();
    XcdBarrier bar; bar.bar = (unsigned*)(F.ctl + CW_BAR); bar.x = 0; bar.st = nullptr;
    if (!MK_PER_PHASE) bar = xcd_barrier_post((unsigned*)(F.ctl + CW_BAR), F.MISC + 8);
    const int lo = args.ph_lo, hi = args.ph_hi;

    PHASE(0, C_PRO, p0_prologue(F););
    PH_END(0);
    PHASE(1, C_THIN, p_modulate0(F););
    PH_END(1);
    mixer_a<0, 0, 2>(F, bar, lo, hi);  mlp_half<0, 7>(F, bar, lo, hi);
    mixer_b<1, 11>(F, bar, lo, hi);    mlp_half<1, 15>(F, bar, lo, hi);
    mixer_c<2, 19>(F, bar, lo, hi);    mlp_half<2, 22>(F, bar, lo, hi);
    mixer_a<3, 1, 26>(F, bar, lo, hi); mlp_half<3, 31>(F, bar, lo, hi);
}

extern "C" void kernel_launch(void* const* d_in, const int* in_sizes, int n_in, void* d_out, int out_size, void* d_ws, size_t ws_size, hipStream_t stream) {
    static int grid = 0;
    if (grid == 0) {
        if (n_in != 23 || out_size != (int)OUT_TOTAL || ws_size < WS_END) { fprintf(stderr, "kernel_launch: unexpected shapes: n_in %d out %d ws %zu (need %zu)\n", n_in, out_size, ws_size, (size_t)WS_END); grid = -1; return; }
        int dev = 0, cus = 0, per_cu = 0;
        if (hipGetDevice(&dev) != hipSuccess || hipDeviceGetAttribute(&cus, hipDeviceAttributeMultiprocessorCount, dev) != hipSuccess) { fprintf(stderr, "kernel_launch: device query failed\n"); grid = -1; return; }
        if (hipFuncSetAttribute((const void*)mk_fwd, hipFuncAttributeMaxDynamicSharedMemorySize, LDS_BYTES) != hipSuccess) { fprintf(stderr, "kernel_launch: hipFuncSetAttribute failed\n"); grid = -1; return; }
        if (hipOccupancyMaxActiveBlocksPerMultiprocessor(&per_cu, (const void*)mk_fwd, NWAVES * 64, LDS_BYTES) != hipSuccess || per_cu < 1)
            fprintf(stderr, "kernel_launch: note: occupancy query reports %d workgroups per CU\n", per_cu);
        (void)hipGetLastError();
        grid = cus;
        if (grid != 256) fprintf(stderr, "kernel_launch: note: %d CUs (tuned for 256)\n", grid);
    }
    if (grid < 0) return;
    if (hipMemsetAsync((char*)d_ws + WS_CTL, 0, CTL_ZERO_BYTES, stream) != hipSuccess) { fprintf(stderr, "kernel_launch: memset failed\n"); return; }
    Args a{};
    for (int i = 0; i < 23; ++i) a.in[i] = (const float*)d_in[i];
    a.out = (float*)d_out; a.ws = (unsigned char*)d_ws; a.pad = 0;
#if MK_PER_PHASE
    for (int p = 0; p < N_PHASES; ++p) { a.ph_lo = p; a.ph_hi = p + 1; a.li = p;
        hipLaunchKernelGGL(mk_fwd, dim3(grid), dim3(NWAVES * 64), LDS_BYTES, stream, a); }
#else
    a.ph_lo = 0; a.ph_hi = N_PHASES; a.li = 0;
    hipLaunchKernelGGL(mk_fwd, dim3(grid), dim3(NWAVES * 64), LDS_BYTES, stream, a);
#endif
    const hipError_t le = hipPeekAtLastError();
    if (le != hipSuccess) fprintf(stderr, "kernel_launch: launch failed: %s\n", hipGetErrorName(le));
}
```
